# Optimizing an MI355X kernel written in HIP

```python
import math
import jax, jax.numpy as jnp
from jax import lax
import numpy as np

D_MODEL = 1024
BATCH = 4
SEQ = 8192
DEPTH = 2

HEAD_DIM = 64
ROT_DIM = HEAD_DIM // 4
ROPE_THETA = 500000.0
Q_BLOCK = 128
EPS = 1e-6

DIFF_HEADS = 4
DIFF_VDIM = 2 * HEAD_DIM
A_Q = DIFF_HEADS * 2 * HEAD_DIM
A_K = DIFF_HEADS * 2 * HEAD_DIM
A_V = DIFF_HEADS * DIFF_VDIM
FOX_HEADS = 8
B_Q = FOX_HEADS * HEAD_DIM
B_K = FOX_HEADS * HEAD_DIM
B_V = FOX_HEADS * HEAD_DIM
B_F = FOX_HEADS
EVEN_WIDTHS = (A_Q, A_K, A_V, B_Q, B_K, B_V, B_F)
EVEN_IN = A_Q + A_K + A_V + B_Q + B_K + B_V + B_F
EVEN_MIX = A_V + B_V

DSA_HEADS = 16
C_Q = DSA_HEADS * HEAD_DIM
C_K = DSA_HEADS * HEAD_DIM
C_V = DSA_HEADS * HEAD_DIM
IDX_HEADS = 8
IDX_DIM = 64
IDX_Q = IDX_HEADS * IDX_DIM
IDX_K = IDX_DIM
IDX_W = IDX_HEADS
TOPK_MAX = 256
ODD_WIDTHS = (C_Q, C_K, C_V, IDX_Q, IDX_K, IDX_W)
ODD_IN = C_Q + C_K + C_V + IDX_Q + IDX_K + IDX_W
ODD_MIX = C_V

D_FF = 4 * D_MODEL
N_EVEN = (DEPTH + 1) // 2
N_ODD = DEPTH // 2

kernel_name = "hybrid_diff_fox_dsa_block"


def _split(x, widths):
    outs, off = [], 0
    for w in widths:
        outs.append(x[..., off:off + w])
        off += w
    return outs


def rmsnorm(x, g):
    xf = x.astype(jnp.float32)
    y = xf * lax.rsqrt(jnp.mean(xf * xf, axis=-1, keepdims=True) + EPS) * g.astype(jnp.float32)
    return y.astype(x.dtype)


def layernorm(x, g, b):
    xf = x.astype(jnp.float32)
    mu = jnp.mean(xf, axis=-1, keepdims=True)
    var = jnp.mean(jnp.square(xf - mu), axis=-1, keepdims=True)
    y = (xf - mu) * lax.rsqrt(var + EPS) * g.astype(jnp.float32) + b.astype(jnp.float32)
    return y.astype(x.dtype)


def rope_tables(seq):
    pos = jnp.arange(seq, dtype=jnp.float32)
    inv_freq = ROPE_THETA ** (-jnp.arange(0, ROT_DIM, 2, dtype=jnp.float32) / ROT_DIM)
    ang = pos[:, None] * inv_freq[None, :]
    return jnp.cos(ang)[:, None, :], jnp.sin(ang)[:, None, :]


def partial_rope(x, cos, sin):
    xf = x.astype(jnp.float32)
    half = ROT_DIM // 2
    x1, x2, xp = xf[..., :half], xf[..., half:ROT_DIM], xf[..., ROT_DIM:]
    y = jnp.concatenate([x1 * cos - x2 * sin, x2 * cos + x1 * sin, xp], axis=-1)
    return y.astype(x.dtype)


def _unblock(o, b, s):
    return jnp.moveaxis(o, 0, 1).reshape((b, s) + o.shape[3:])


def even_mixer(h, w_in, b_f, lq1, lk1, lq2, lk2, sub_g, w_out, lambda_init, cos, sin):
    b, s, _ = h.shape
    proj = h @ w_in
    a_q, a_k, a_v, f_q, f_k, f_v, f_logit = _split(proj, EVEN_WIDTHS)
    a_q = partial_rope(a_q.reshape(b, s, DIFF_HEADS * 2, HEAD_DIM), cos, sin).reshape(b, s, DIFF_HEADS, 2, HEAD_DIM)
    a_k = partial_rope(a_k.reshape(b, s, DIFF_HEADS * 2, HEAD_DIM), cos, sin).reshape(b, s, DIFF_HEADS, 2, HEAD_DIM)
    a_v = a_v.reshape(b, s, DIFF_HEADS, DIFF_VDIM)
    lam = (jnp.exp(jnp.sum(lq1.astype(jnp.float32) * lk1.astype(jnp.float32)))
           - jnp.exp(jnp.sum(lq2.astype(jnp.float32) * lk2.astype(jnp.float32)))
           + lambda_init)
    f_q = f_q.reshape(b, s, FOX_HEADS, HEAD_DIM)
    f_k = f_k.reshape(b, s, FOX_HEADS, HEAD_DIM)
    f_v = f_v.reshape(b, s, FOX_HEADS, HEAD_DIM)
    log_f = jax.nn.log_sigmoid(f_logit.astype(jnp.float32) + b_f.astype(jnp.float32))
    c = jnp.transpose(jnp.cumsum(log_f, axis=1), (0, 2, 1))

    scale = HEAD_DIM ** -0.5
    kpos = jnp.arange(s)

    def block(i):
        start = i * Q_BLOCK
        qpos = start + jnp.arange(Q_BLOCK)
        causal = kpos[None, :] <= qpos[:, None]
        qa = lax.dynamic_slice_in_dim(a_q, start, Q_BLOCK, axis=1)
        sa = jnp.einsum('bqhcd,bkhcd->bhcqk', qa, a_k).astype(jnp.float32) * scale
        pa = jax.nn.softmax(jnp.where(causal, sa, -jnp.inf), axis=-1)
        attn = pa[:, :, 0] - lam * pa[:, :, 1]
        oa = jnp.einsum('bhqk,bkhe->bqhe', attn, a_v)
        qb = lax.dynamic_slice_in_dim(f_q, start, Q_BLOCK, axis=1)
        cq = lax.dynamic_slice_in_dim(c, start, Q_BLOCK, axis=2)
        sb = jnp.einsum('bqhd,bkhd->bhqk', qb, f_k).astype(jnp.float32) * scale
        sb = sb + cq[..., None] - c[:, :, None, :]
        pb = jax.nn.softmax(jnp.where(causal, sb, -jnp.inf), axis=-1)
        ob = jnp.einsum('bhqk,bkhd->bqhd', pb, f_v)
        return oa.astype(h.dtype), ob.astype(h.dtype)

    oa, ob = lax.map(block, jnp.arange(s // Q_BLOCK))
    oa = _unblock(oa, b, s)
    ob = _unblock(ob, b, s)
    oa = (rmsnorm(oa, sub_g) * (1.0 - lambda_init)).astype(h.dtype)
    mixed = jnp.concatenate([oa.reshape(b, s, A_V), ob.reshape(b, s, B_V)], axis=-1)
    return mixed @ w_out


def odd_mixer(h, w_in, ln_g, ln_b, w_out, cos, sin):
    b, s, _ = h.shape
    proj = h @ w_in
    q, k, v, iq, ik, iw = _split(proj, ODD_WIDTHS)
    q = partial_rope(q.reshape(b, s, DSA_HEADS, HEAD_DIM), cos, sin)
    k = partial_rope(k.reshape(b, s, DSA_HEADS, HEAD_DIM), cos, sin)
    v = v.reshape(b, s, DSA_HEADS, HEAD_DIM)
    iq = partial_rope(iq.reshape(b, s, IDX_HEADS, IDX_DIM), cos, sin)
    ik = partial_rope(layernorm(ik, ln_g, ln_b)[:, :, None, :], cos, sin)[:, :, 0, :]
    iw = iw.astype(jnp.float32) * IDX_HEADS ** -0.5
    k_sel = min(TOPK_MAX, s // 4)
    scale = HEAD_DIM ** -0.5
    kpos = jnp.arange(s)
    gather = jax.vmap(lambda arr, ids: arr[ids])

    def block(i):
        start = i * Q_BLOCK
        qpos = start + jnp.arange(Q_BLOCK)
        causal = kpos[None, :] <= qpos[:, None]
        iqb = lax.dynamic_slice_in_dim(iq, start, Q_BLOCK, axis=1)
        iwb = lax.dynamic_slice_in_dim(iw, start, Q_BLOCK, axis=1)
        logits = jnp.einsum('bqhd,bkd->bqhk', iqb, ik).astype(jnp.float32) * IDX_DIM ** -0.5
        score = jnp.einsum('bqhk,bqh->bqk', jax.nn.relu(logits), iwb)
        score = jnp.where(causal[None], score, -jnp.inf)
        _, idx = lax.top_k(score, k_sel)
        valid = idx <= qpos[None, :, None]
        kg = gather(k, idx)
        vg = gather(v, idx)
        qb = lax.dynamic_slice_in_dim(q, start, Q_BLOCK, axis=1)
        sc = jnp.einsum('bqhd,bqjhd->bhqj', qb, kg).astype(jnp.float32) * scale
        p = jax.nn.softmax(jnp.where(valid[:, None], sc, -jnp.inf), axis=-1)
        o = jnp.einsum('bhqj,bqjhd->bqhd', p, vg)
        return o.astype(h.dtype)

    o = _unblock(lax.map(block, jnp.arange(s // Q_BLOCK)), b, s)
    return o.reshape(b, s, ODD_MIX) @ w_out


def sqrelu_mlp(h, w1, w2):
    return jnp.square(jax.nn.relu(h @ w1)) @ w2


def setup_inputs(seed: int = 0) -> dict:
    key = jax.random.key(seed)
    ks = jax.random.split(key, 19)
    f32 = jnp.float32
    nrm = lambda k, shp, sc: jax.random.normal(k, shp, f32) * sc
    return {
        "x": jax.random.normal(ks[0], (BATCH, SEQ, D_MODEL), f32),
        "norm_mix": 1.0 + nrm(ks[1], (DEPTH, D_MODEL), 0.02),
        "w_in_even": nrm(ks[2], (N_EVEN, D_MODEL, EVEN_IN), D_MODEL ** -0.5),
        "b_forget": jax.random.uniform(ks[3], (N_EVEN, FOX_HEADS), f32, 1.0, 4.0),
        "lambda_q1": nrm(ks[4], (N_EVEN, HEAD_DIM), 0.1),
        "lambda_k1": nrm(ks[5], (N_EVEN, HEAD_DIM), 0.1),
        "lambda_q2": nrm(ks[6], (N_EVEN, HEAD_DIM), 0.1),
        "lambda_k2": nrm(ks[7], (N_EVEN, HEAD_DIM), 0.1),
        "diff_subln_g": 1.0 + nrm(ks[8], (N_EVEN, DIFF_VDIM), 0.02),
        "w_out_even": nrm(ks[9], (N_EVEN, EVEN_MIX, D_MODEL), EVEN_MIX ** -0.5),
        "w_in_odd": nrm(ks[10], (N_ODD, D_MODEL, ODD_IN), D_MODEL ** -0.5),
        "idx_ln_g": 1.0 + nrm(ks[11], (N_ODD, IDX_DIM), 0.02),
        "idx_ln_b": nrm(ks[12], (N_ODD, IDX_DIM), 0.02),
        "w_out_odd": nrm(ks[13], (N_ODD, ODD_MIX, D_MODEL), ODD_MIX ** -0.5),
        "norm_mlp": 1.0 + nrm(ks[14], (DEPTH, D_MODEL), 0.02),
        "w_mlp_in": nrm(ks[15], (DEPTH, D_MODEL, D_FF), D_MODEL ** -0.5),
        "w_mlp_out": nrm(ks[16], (DEPTH, D_FF, D_MODEL), D_FF ** -0.5),
        "norm_final": 1.0 + nrm(ks[17], (D_MODEL,), 0.02),
    }


def reference(x, norm_mix, w_in_even, b_forget, lambda_q1, lambda_k1, lambda_q2, lambda_k2,
              diff_subln_g, w_out_even, w_in_odd, idx_ln_g, idx_ln_b, w_out_odd,
              norm_mlp, w_mlp_in, w_mlp_out, norm_final):
    cos, sin = rope_tables(x.shape[1])
    h = x
    for layer in range(DEPTH):
        j = layer // 2
        hn = rmsnorm(h, norm_mix[layer])
        if layer % 2 == 0:
            lambda_init = 0.8 - 0.6 * math.exp(-0.3 * layer)
            mix = even_mixer(hn, w_in_even[j], b_forget[j], lambda_q1[j], lambda_k1[j],
                             lambda_q2[j], lambda_k2[j], diff_subln_g[j], w_out_even[j],
                             lambda_init, cos, sin)
        else:
            mix = odd_mixer(hn, w_in_odd[j], idx_ln_g[j], idx_ln_b[j], w_out_odd[j], cos, sin)
        h = h + mix.astype(h.dtype)
        h = h + sqrelu_mlp(rmsnorm(h, norm_mlp[layer]), w_mlp_in[layer], w_mlp_out[layer]).astype(h.dtype)
    return rmsnorm(h, norm_final)
```

```cpp
#include <hip/hip_runtime.h>
#include <hip/hip_cooperative_groups.h>
#include <cstdint>
#include <cstdio>
#include <cmath>
namespace cg = cooperative_groups;

typedef unsigned short bf16_t;
typedef short bf16x8 __attribute__((ext_vector_type(8)));
typedef short s16x4 __attribute__((ext_vector_type(4)));
typedef float f32x16 __attribute__((ext_vector_type(16)));
typedef float f32x4 __attribute__((ext_vector_type(4)));
typedef float f32x2 __attribute__((ext_vector_type(2)));
typedef unsigned u32x4 __attribute__((ext_vector_type(4)));
typedef unsigned u32x2 __attribute__((ext_vector_type(2)));
typedef __bf16 bf2_t __attribute__((ext_vector_type(2)));
typedef unsigned long long u64;

#define DI __device__ __forceinline__
#define MFMA32(a, b, c) __builtin_amdgcn_mfma_f32_32x32x16_bf16((a), (b), (c), 0, 0, 0)

constexpr int T_TOK = 32768, SEQ = 8192, DM = 1024, NTHREADS = 512;
constexpr float EPS = 1e-6f;
constexpr float QSCALE = 0.125f * 1.4426950408889634f;
constexpr float LOG2E = 1.4426950408889634f;
constexpr int P0_PITCH = 3072, P1_PITCH = 3584;

constexpr size_t WS_WT_IN0 = 0;
constexpr size_t WS_WT_OUT0 = WS_WT_IN0 + (size_t)3328 * 1024 * 2;
constexpr size_t WS_WT_IN1 = WS_WT_OUT0 + (size_t)1024 * 1024 * 2;
constexpr size_t WS_WT_OUT1 = WS_WT_IN1 + (size_t)3840 * 1024 * 2;
constexpr size_t WS_WT_UP0 = WS_WT_OUT1 + (size_t)1024 * 1024 * 2;
constexpr size_t WS_WT_UP1 = WS_WT_UP0 + (size_t)4096 * 1024 * 2;
constexpr size_t WS_WT_DN0 = WS_WT_UP1 + (size_t)4096 * 1024 * 2;
constexpr size_t WS_WT_DN1 = WS_WT_DN0 + (size_t)4096 * 1024 * 2;
constexpr size_t WS_HB = WS_WT_DN1 + (size_t)4096 * 1024 * 2;
constexpr size_t WS_PBUF = WS_HB + (size_t)T_TOK * 1024 * 2;
constexpr size_t WS_VT = WS_PBUF + (size_t)T_TOK * 3584 * 2;
constexpr size_t WS_MIXED = WS_VT + (size_t)T_TOK * 1024 * 2;
constexpr size_t WS_BITMASK = WS_MIXED + (size_t)T_TOK * 1024 * 2;
constexpr size_t WS_IKB = WS_BITMASK + (size_t)T_TOK * 128 * 8;
constexpr size_t WS_IW = WS_IKB + (size_t)T_TOK * 64 * 2;
constexpr size_t WS_LOGF = WS_IW + (size_t)T_TOK * 8 * 4;
constexpr size_t WS_C2 = WS_LOGF + (size_t)T_TOK * 8 * 4;
constexpr size_t WS_SUMSQ = WS_C2 + (size_t)T_TOK * 8 * 4;
constexpr size_t WS_ROPE = WS_SUMSQ + (size_t)5 * T_TOK * 4;
constexpr size_t WS_BND = WS_ROPE + (size_t)SEQ * 16 * 4;
constexpr size_t WS_BAR = WS_BND + 256;
constexpr size_t WS_END = WS_BAR + 256;
static_assert(WS_END <= (size_t)536870912, "workspace too large");
static_assert((size_t)T_TOK * 4096 * 2 <= WS_MIXED - WS_PBUF, "U overlay too large");

constexpr int LDS_BYTES = 140288;
constexpr int REP_PH = -1;

struct Params {
    const float* in[18];
    float* out;
    unsigned char* ws;
    float inv_freq[8];
    int ph_lo, ph_hi;
};

DI unsigned pk_bf16(float a, float b) { f32x2 v = {a, b}; bf2_t r = __builtin_convertvector(v, bf2_t); return __builtin_bit_cast(unsigned, r); }
DI bf16_t to_bf16(float a) { return (bf16_t)(pk_bf16(a, 0.f) & 0xffffu); }
DI void store4_bf16(bf16_t* p, float a, float b, float c, float d) { u32x2 w; w.x = pk_bf16(a, b); w.y = pk_bf16(c, d); *(u32x2*)p = w; }
DI int crow(int i, int hh) { return (i & 3) + 8 * (i >> 2) + 4 * hh; }
DI float xhalf_sum(float v) { const auto r = __builtin_amdgcn_permlane32_swap(__float_as_uint(v), __float_as_uint(v), false, false); return __uint_as_float(r[0]) + __uint_as_float(r[1]); }
DI float xhalf_max(float v) { const auto r = __builtin_amdgcn_permlane32_swap(__float_as_uint(v), __float_as_uint(v), false, false); return fmaxf(__uint_as_float(r[0]), __uint_as_float(r[1])); }
DI float wave_sum(float v) {
#pragma unroll
    for (int d = 32; d >= 1; d >>= 1) v += __shfl_xor(v, d);
    return v;
}

struct TJob { const float* W; int K, N; const float* gain; bf16_t* dst; int k0, n0; };

DI TJob tjob_decode(const Params& p, int t) {
    unsigned char* ws = p.ws;
    TJob j; int Npad; int tt = t;
    if (tt < 384) { j.W = p.in[2]; j.K = 1024; j.N = 3080; Npad = 3072; j.gain = p.in[1]; j.dst = (bf16_t*)(ws + WS_WT_IN0); }
    else if ((tt -= 384) < 128) { j.W = p.in[9]; j.K = 1024; j.N = 1024; Npad = 1024; j.gain = nullptr; j.dst = (bf16_t*)(ws + WS_WT_OUT0); }
    else if ((tt -= 128) < 480) { j.W = p.in[10]; j.K = 1024; j.N = 3656; Npad = 3840; j.gain = p.in[1] + 1024; j.dst = (bf16_t*)(ws + WS_WT_IN1); }
    else if ((tt -= 480) < 128) { j.W = p.in[13]; j.K = 1024; j.N = 1024; Npad = 1024; j.gain = nullptr; j.dst = (bf16_t*)(ws + WS_WT_OUT1); }
    else if ((tt -= 128) < 512) { j.W = p.in[15]; j.K = 1024; j.N = 4096; Npad = 4096; j.gain = p.in[14]; j.dst = (bf16_t*)(ws + WS_WT_UP0); }
    else if ((tt -= 512) < 512) { j.W = p.in[15] + (size_t)1024 * 4096; j.K = 1024; j.N = 4096; Npad = 4096; j.gain = p.in[14] + 1024; j.dst = (bf16_t*)(ws + WS_WT_UP1); }
    else if ((tt -= 512) < 512) { j.W = p.in[16]; j.K = 4096; j.N = 1024; Npad = 1024; j.gain = nullptr; j.dst = (bf16_t*)(ws + WS_WT_DN0); }
    else { tt -= 512; j.W = p.in[16] + (size_t)4096 * 1024; j.K = 4096; j.N = 1024; Npad = 1024; j.gain = nullptr; j.dst = (bf16_t*)(ws + WS_WT_DN1); }
    const int ntn = Npad >> 7;
    j.k0 = (tt / ntn) * 64; j.n0 = (tt % ntn) * 128;
    return j;
}

DI void tjob_load(const TJob& j, float (&v)[16]) {
    const int tid = threadIdx.x;
#pragma unroll
    for (int i = 0; i < 16; ++i) {
        const int idx = tid + 512 * i, kk = idx >> 7, nn = idx & 127;
        v[i] = (j.n0 + nn < j.N) ? j.W[(size_t)(j.k0 + kk) * j.N + j.n0 + nn] : 0.f;
    }
    if (j.gain) {
#pragma unroll
        for (int i = 0; i < 16; ++i) v[i] *= j.gain[j.k0 + ((tid + 512 * i) >> 7)];
    }
}

DI void phase_prep(const Params& p, unsigned char* lds) {
    float* ldsf = (float*)lds;
    unsigned char* ws = p.ws;
    {
        const int tid = threadIdx.x, GG = (int)gridDim.x;
        constexpr int NT = 3168;
        int t = blockIdx.x;
        float vA[16], vB[16];
        TJob jA{}, jB{};
        if (t < NT) { jA = tjob_decode(p, t); tjob_load(jA, vA); }
        if (t + GG < NT) { jB = tjob_decode(p, t + GG); tjob_load(jB, vB); }
        auto stage = [&](const float (&v)[16]) {
#pragma unroll
            for (int i = 0; i < 16; ++i) { const int idx = tid + 512 * i, kk = idx >> 7, nn = idx & 127; ldsf[nn * 65 + kk] = v[i]; }
        };
        auto writeout = [&](const TJob& j) {
#pragma unroll
            for (int i = 0; i < 8; ++i) {
                const int idx = tid + 512 * i, nn = idx >> 5, kp = (idx & 31) * 2;
                *(unsigned*)(j.dst + (size_t)(j.n0 + nn) * j.K + j.k0 + kp) = pk_bf16(ldsf[nn * 65 + kp], ldsf[nn * 65 + kp + 1]);
            }
        };
        while (t < NT) {
            {
                stage(vA);
                __syncthreads();
                const TJob old = jA;
                if (t + 2 * GG < NT) { jA = tjob_decode(p, t + 2 * GG); tjob_load(jA, vA); }
                writeout(old);
                __syncthreads();
            }
            if (t + GG < NT) {
                stage(vB);
                __syncthreads();
                const TJob old = jB;
                if (t + 3 * GG < NT) { jB = tjob_decode(p, t + 3 * GG); tjob_load(jB, vB); }
                writeout(old);
                __syncthreads();
            }
            t += 2 * GG;
        }
    }
    const int tid = threadIdx.x, lane = tid & 63, wid = tid >> 6;
    const float* x = p.in[0];
    bf16_t* hb = (bf16_t*)(ws + WS_HB);
    float* sumsq = (float*)(ws + WS_SUMSQ);
    for (int r0 = (blockIdx.x * 8 + wid) * 4; r0 < T_TOK; r0 += gridDim.x * 8 * 4) {
        f32x4 xv[4][4];
#pragma unroll
        for (int rr = 0; rr < 4; ++rr)
#pragma unroll
            for (int j = 0; j < 4; ++j) xv[rr][j] = *(const f32x4*)(x + (size_t)(r0 + rr) * 1024 + 4 * lane + 256 * j);
        float ssr[4];
#pragma unroll
        for (int rr = 0; rr < 4; ++rr) {
            const int row = r0 + rr; float ss = 0.f;
#pragma unroll
            for (int j = 0; j < 4; ++j) {
                const f32x4 v = xv[rr][j];
                ss += v[0] * v[0] + v[1] * v[1] + v[2] * v[2] + v[3] * v[3];
                store4_bf16(hb + (size_t)row * 1024 + 4 * lane + 256 * j, v[0], v[1], v[2], v[3]);
            }
            ss = wave_sum(ss); ssr[rr] = ss;
            if (lane == 0) { sumsq[row] = ss; sumsq[T_TOK + row] = 0.f; sumsq[2 * T_TOK + row] = 0.f; sumsq[3 * T_TOK + row] = 0.f; sumsq[4 * T_TOK + row] = 0.f; }
        }
        float a[32];
#pragma unroll
        for (int i = 0; i < 32; ++i) a[i] = 0.f;
        const float* Wl = p.in[2] + 3072; const float* gmix = p.in[1];
#pragma unroll
        for (int j = 0; j < 4; ++j) {
            const f32x4 g4 = *(const f32x4*)(gmix + 4 * lane + 256 * j);
#pragma unroll
            for (int e = 0; e < 4; ++e) {
                const size_t k = (size_t)(4 * lane + 256 * j + e);
                const f32x4 w0 = *(const f32x4*)(Wl + k * 3080), w1 = *(const f32x4*)(Wl + k * 3080 + 4);
#pragma unroll
                for (int rr = 0; rr < 4; ++rr) {
                    const float xk = xv[rr][j][e] * g4[e];
#pragma unroll
                    for (int c = 0; c < 4; ++c) { a[rr * 8 + c] += xk * w0[c]; a[rr * 8 + 4 + c] += xk * w1[c]; }
                }
            }
        }
        float b16[16], b8[8], b4[4], b2[2];
        { const bool bt = (lane & 32) != 0;
#pragma unroll
          for (int i = 0; i < 16; ++i) { const float snd = bt ? a[i] : a[i + 16], kp = bt ? a[i + 16] : a[i]; b16[i] = kp + __shfl_xor(snd, 32); } }
        { const bool bt = (lane & 16) != 0;
#pragma unroll
          for (int i = 0; i < 8; ++i) { const float snd = bt ? b16[i] : b16[i + 8], kp = bt ? b16[i + 8] : b16[i]; b8[i] = kp + __shfl_xor(snd, 16); } }
        { const bool bt = (lane & 8) != 0;
#pragma unroll
          for (int i = 0; i < 4; ++i) { const float snd = bt ? b8[i] : b8[i + 4], kp = bt ? b8[i + 4] : b8[i]; b4[i] = kp + __shfl_xor(snd, 8); } }
        { const bool bt = (lane & 4) != 0;
#pragma unroll
          for (int i = 0; i < 2; ++i) { const float snd = bt ? b4[i] : b4[i + 2], kp = bt ? b4[i + 2] : b4[i]; b2[i] = kp + __shfl_xor(snd, 4); } }
        float tot;
        { const bool bt = (lane & 2) != 0; const float snd = bt ? b2[0] : b2[1], kp = bt ? b2[1] : b2[0]; tot = kp + __shfl_xor(snd, 2); }
        tot += __shfl_xor(tot, 1);
        {
            const int rr = lane >> 4, c = (lane >> 1) & 7;
            const float ssm = (rr == 0) ? ssr[0] : ((rr == 1) ? ssr[1] : ((rr == 2) ? ssr[2] : ssr[3]));
            const float v = tot * rsqrtf(ssm * (1.0f / 1024.0f) + EPS) + p.in[3][c];
            if ((lane & 1) == 0) ((float*)(ws + WS_LOGF))[(size_t)(r0 + rr) * 8 + c] = fminf(v, 0.f) - __logf(1.0f + __expf(-fabsf(v)));
        }
    }
    if (blockIdx.x == 0 && threadIdx.x < 64) { ((unsigned*)(ws + WS_BND))[threadIdx.x] = 0u; ((unsigned*)(ws + WS_BAR))[threadIdx.x] = 0u; }
    float* rope = (float*)(ws + WS_ROPE);
    for (int e = blockIdx.x * NTHREADS + tid; e < SEQ * 8; e += gridDim.x * NTHREADS) {
        const int s = e >> 3, i = e & 7;
        const float ang = (float)s * p.inv_freq[i];
        const double a = (double)ang; const double k = rint(a * 0.15915494309189535); const double r = a - k * 6.283185307179586;
        const float rf = (float)r;
        rope[s * 16 + i] = __cosf(rf); rope[s * 16 + 8 + i] = __sinf(rf);
    }
}

namespace pg8 {
#define PG8_LAS __attribute__((address_space(3)))
typedef unsigned short bf16_t;
typedef short bf16x8 __attribute__((ext_vector_type(8)));
typedef float f32x4 __attribute__((ext_vector_type(4)));
typedef unsigned u32x4 __attribute__((ext_vector_type(4)));
constexpr int BM = 256, BK = 64, HALF = 128, HTB = HALF * BK * 2  , STAGE_BYTES = 8 * HTB, NXCD = 8, WGM = 8;

__host__ __device__ __forceinline__ int lds_byte(int r, int c) { const int st = (r >> 4) * 2 + (c >> 5), rr = r & 15, cc = c & 31, ob = rr * 64 + cc * 2; return st * 1024 + (ob ^ (((ob >> 9) & 1) << 5)); }
__host__ __device__ __forceinline__ void stage_rc(int b, int& R, int& C) { const int st = b / 1024, sb = b % 1024, swz = sb ^ (((sb >> 9) & 1) << 5); R = (st >> 1) * 16 + swz / 64; C = (st & 1) * 32 + (swz % 64) / 2; }
__host__ __device__ __forceinline__ int perm32(int rho) { const int n = rho >> 4, i = rho & 15; return 8 * (i >> 2) + 4 * n + (i & 3); }

struct Unit { int pm, pn; };
struct Gemm { const bf16_t* A; const bf16_t* Bt; int M, N, K; };

struct StaticOrder {
    int nM, nN, nwg, G, c;
    __host__ __device__ void init(int M, int N, int G_, int c_) { nM = M / BM; nN = N / BM; nwg = nM * nN; G = G_; c = c_; }
    __host__ __device__ bool next(int i, Unit& u) const {
        const long L = (long)i * G + c; if (L >= nwg) return false;
        int wgid = (int)L; { const int q = nwg / NXCD, r = nwg % NXCD, xcd = wgid % NXCD, off = wgid / NXCD; wgid = (xcd < r ? xcd * (q + 1) : r * (q + 1) + (xcd - r) * q) + off; }
        const int nig = WGM * nN, gid = wgid / nig, fm = gid * WGM, gsz = (nM - fm) < WGM ? (nM - fm) : WGM;
        u.pm = fm + ((wgid % nig) % gsz); u.pn = (wgid % nig) / gsz; return true;
    }
    __device__ __forceinline__ void a_ready(const Unit&) const {}
    __device__ __forceinline__ void done(const Unit&) const {}
};
__device__ __forceinline__ unsigned cvt_pk_bf16(float lo, float hi) { unsigned r; asm volatile("v_cvt_pk_bf16_f32 %0, %1, %2" : "=v"(r) : "v"(lo), "v"(hi)); return r; }
typedef float f32x2 __attribute__((ext_vector_type(2)));
template <class Epi, class Sched, bool ALIGN_EPI = false, bool SP2 = false>
__device__ __forceinline__ void gemm_phase(PG8_LAS unsigned char* lds, const Gemm g, const Sched& S, const Epi& E) {
    const int tid = threadIdx.x, wid = __builtin_amdgcn_readfirstlane(tid >> 6), lane = tid & 63, wr = wid >> 2, wc = wid & 3, fr = lane & 15, fq = lane >> 4;
    const int K = g.K, nt = K / BK;
    unsigned voffA[2], voffB[2];
#pragma unroll
    for (int i = 0; i < 2; ++i) { int R, C; stage_rc(tid * 16 + i * 8192, R, C); const int Rb = Epi::PERM ? ((R & ~31) + perm32(R & 31)) : R;
        voffA[i] = (unsigned)(R * K + C) * 2u; voffB[i] = (unsigned)(Rb * K + C) * 2u; }
    const size_t kstep = (size_t)(BK * 2);
    const size_t hstep = (size_t)HALF * K * 2;
    const size_t tstep = 2 * hstep;
    const unsigned ldsw = (unsigned)wid * 1024u;
    const int aoff = lds_byte(wr * 64 + fr, fq * 8), boff = lds_byte(wc * 32 + fr, fq * 8);
#define PG8_SA(b, h) (((b) * 2 + (h)) * HTB)
#define PG8_SB(b, h) ((4 + (b) * 2 + (h)) * HTB)
#define PG8_STAGE(bufoff, gbase, voff) do { _Pragma("unroll") for (int _i = 0; _i < 2; ++_i) \
        __builtin_amdgcn_global_load_lds((const unsigned*)((const char*)(gbase) + (voff)[_i]), (PG8_LAS unsigned*)(lds + (bufoff) + ldsw + _i * 8192), 16, 0, 0); } while (0)
#define PG8_LDA(dst, b, h) do { _Pragma("unroll") for (int m = 0; m < 4; ++m) _Pragma("unroll") for (int k = 0; k < 2; ++k) dst[m][k] = *(const PG8_LAS bf16x8*)(lds + PG8_SA(b, h) + aoff + m * 2048 + k * 1024); } while (0)
#define PG8_LDB(dst, b, h) do { _Pragma("unroll") for (int n = 0; n < 2; ++n) _Pragma("unroll") for (int k = 0; k < 2; ++k) dst[n][k] = *(const PG8_LAS bf16x8*)(lds + PG8_SB(b, h) + boff + n * 2048 + k * 1024); } while (0)
#define PG8_MMA(ai, bj, At, Bt) do { __builtin_amdgcn_s_setprio(1); _Pragma("unroll") for (int m = 0; m < 4; ++m) _Pragma("unroll") for (int n = 0; n < 2; ++n) _Pragma("unroll") for (int k = 0; k < 2; ++k) \
        acc[ai][bj][m][n] = __builtin_amdgcn_mfma_f32_16x16x32_bf16(Bt[n][k], At[m][k], acc[ai][bj][m][n], 0, 0, 0); __builtin_amdgcn_s_setprio(0); } while (0)
#define PG8_WAIT_V(n) asm volatile("s_waitcnt vmcnt(" #n ")" ::: "memory")
#define PG8_WAIT_L(n) asm volatile("s_waitcnt lgkmcnt(" #n ")" ::: "memory")
#define PG8_BAR __builtin_amdgcn_s_barrier()
#define PG8_SCHED __builtin_amdgcn_sched_barrier(0)
    Unit cur, nxt; int ui = 0;
    if (!S.next(0, cur)) return;
    f32x4 acc[2][2][4][2];
#pragma unroll
    for (int a = 0; a < 2; ++a)
#pragma unroll
        for (int b = 0; b < 2; ++b)
#pragma unroll
            for (int m = 0; m < 4; ++m)
#pragma unroll
                for (int n = 0; n < 2; ++n) acc[a][b][m][n] = (f32x4){0.f, 0.f, 0.f, 0.f};
    bf16x8 At[4][2], B0[2][2], B1[2][2];
    const char* cA = (const char*)g.A + (size_t)cur.pm * tstep; const char* cB = (const char*)g.Bt + (size_t)cur.pn * tstep;
    S.a_ready(cur);
    if constexpr (SP2) {
        PG8_STAGE(PG8_SB(0, 0), cB, voffB); PG8_STAGE(PG8_SB(0, 1), cB + hstep, voffB); PG8_STAGE(PG8_SA(0, 0), cA, voffA); PG8_STAGE(PG8_SA(0, 1), cA + hstep, voffA);
        if (wr == 1) PG8_BAR;
        PG8_WAIT_V(2); PG8_BAR;
        PG8_STAGE(PG8_SB(1, 0), cB + kstep, voffB); PG8_STAGE(PG8_SA(1, 0), cA + kstep, voffA); PG8_STAGE(PG8_SB(1, 1), cB + hstep + kstep, voffB);
        PG8_WAIT_V(6); PG8_BAR;
    } else {
        PG8_STAGE(PG8_SB(0, 0), cB, voffB); PG8_STAGE(PG8_SA(0, 0), cA, voffA); PG8_STAGE(PG8_SB(0, 1), cB + hstep, voffB); PG8_STAGE(PG8_SA(0, 1), cA + hstep, voffA);
        if (wr == 1) PG8_BAR;
        PG8_WAIT_V(4); PG8_BAR;
        PG8_STAGE(PG8_SB(1, 0), cB + kstep, voffB); PG8_STAGE(PG8_SA(1, 0), cA + kstep, voffA); PG8_STAGE(PG8_SB(1, 1), cB + hstep + kstep, voffB);
        PG8_WAIT_V(6); PG8_BAR;
    }
    for (;;) {
        const bool has_next = S.next(ui + 1, nxt);
        const char* nA = has_next ? (const char*)g.A + (size_t)nxt.pm * tstep : cA; const char* nB = has_next ? (const char*)g.Bt + (size_t)nxt.pn * tstep : cB;
        for (int t = 0; t < nt; t += 2) {
            const bool last = (t == nt - 2);
            const char* a1 = cA + (size_t)(t + 1) * kstep;
            const char* a2 = last ? nA : cA + (size_t)(t + 2) * kstep; const char* b2 = last ? nB : cB + (size_t)(t + 2) * kstep;
            const char* a3 = a2 + kstep; const char* b3 = b2 + kstep;
            if (last && has_next) S.a_ready(nxt);
            if constexpr (SP2) {
            PG8_LDB(B0, 0, 0); PG8_LDB(B1, 0, 1); PG8_SCHED; PG8_LDA(At, 0, 0); PG8_STAGE(PG8_SA(1, 1), a1 + hstep, voffA);
            PG8_WAIT_V(8); PG8_WAIT_L(0); PG8_BAR; PG8_MMA(0, 0, At, B0); PG8_MMA(0, 1, At, B1); PG8_BAR; PG8_SCHED;
            PG8_LDA(At, 0, 1); PG8_STAGE(PG8_SB(0, 0), b2, voffB); PG8_STAGE(PG8_SB(0, 1), b2 + hstep, voffB); PG8_STAGE(PG8_SA(0, 0), a2, voffA);
            PG8_WAIT_V(8); PG8_WAIT_L(0); PG8_BAR; PG8_MMA(1, 0, At, B0); PG8_MMA(1, 1, At, B1); PG8_BAR; PG8_SCHED;
            PG8_LDB(B0, 1, 0); PG8_LDB(B1, 1, 1); PG8_SCHED; PG8_LDA(At, 1, 0); PG8_STAGE(PG8_SA(0, 1), a2 + hstep, voffA);
            PG8_WAIT_V(8); PG8_WAIT_L(0); PG8_BAR; PG8_MMA(0, 0, At, B0); PG8_MMA(0, 1, At, B1); PG8_BAR; PG8_SCHED;
            PG8_LDA(At, 1, 1); PG8_STAGE(PG8_SB(1, 0), b3, voffB); PG8_STAGE(PG8_SB(1, 1), b3 + hstep, voffB); PG8_STAGE(PG8_SA(1, 0), a3, voffA);
            PG8_WAIT_V(8); PG8_WAIT_L(0); PG8_BAR; PG8_MMA(1, 0, At, B0); PG8_MMA(1, 1, At, B1); PG8_BAR; PG8_SCHED;
            } else {
            PG8_LDB(B0, 0, 0); PG8_SCHED; PG8_LDA(At, 0, 0); PG8_STAGE(PG8_SA(1, 1), a1 + hstep, voffA);
            PG8_WAIT_L(8); PG8_BAR; PG8_WAIT_L(0); PG8_MMA(0, 0, At, B0); PG8_BAR; PG8_SCHED;
            PG8_LDB(B1, 0, 1); PG8_STAGE(PG8_SB(0, 0), b2, voffB);
            PG8_BAR; PG8_WAIT_L(0); PG8_MMA(0, 1, At, B1); PG8_BAR;
            PG8_LDA(At, 0, 1); PG8_STAGE(PG8_SA(0, 0), a2, voffA);
            PG8_BAR; PG8_WAIT_L(0); PG8_MMA(1, 0, At, B0); PG8_BAR; PG8_SCHED;
            PG8_STAGE(PG8_SB(0, 1), b2 + hstep, voffB);
            PG8_WAIT_V(6); PG8_BAR; PG8_MMA(1, 1, At, B1); PG8_BAR;
            PG8_LDB(B0, 1, 0); PG8_SCHED; PG8_LDA(At, 1, 0); PG8_STAGE(PG8_SA(0, 1), a2 + hstep, voffA);
            PG8_WAIT_L(8); PG8_BAR; PG8_WAIT_L(0); PG8_MMA(0, 0, At, B0); PG8_BAR; PG8_SCHED;
            PG8_LDB(B1, 1, 1); PG8_STAGE(PG8_SB(1, 0), b3, voffB);
            PG8_BAR; PG8_WAIT_L(0); PG8_MMA(0, 1, At, B1); PG8_BAR;
            PG8_LDA(At, 1, 1); PG8_STAGE(PG8_SA(1, 0), a3, voffA);
            PG8_BAR; PG8_WAIT_L(0); PG8_MMA(1, 0, At, B0); PG8_BAR; PG8_SCHED;
            PG8_STAGE(PG8_SB(1, 1), b3 + hstep, voffB);
            PG8_WAIT_V(6); PG8_BAR; PG8_MMA(1, 1, At, B1); PG8_BAR;
            }
        }
        if constexpr (ALIGN_EPI) { if (wr == 0) PG8_BAR; }
        if constexpr (!Epi::AFTER_DRAIN) { E(acc, cur, wr, wc, fr, fq); S.done(cur); }
        if (!has_next) break;
#pragma unroll
        for (int a = 0; a < 2; ++a)
#pragma unroll
            for (int b = 0; b < 2; ++b)
#pragma unroll
                for (int m = 0; m < 4; ++m)
#pragma unroll
                    for (int n = 0; n < 2; ++n) acc[a][b][m][n] = (f32x4){0.f, 0.f, 0.f, 0.f};
        cur = nxt; cA = nA; cB = nB; ++ui;
        if constexpr (ALIGN_EPI) { if (wr == 1) PG8_BAR; }
    }
    PG8_WAIT_V(0);
    if constexpr (!ALIGN_EPI) { if (wr == 0) PG8_BAR; }
    PG8_BAR;
    if constexpr (Epi::AFTER_DRAIN) { E.fused(acc, cur, wr, wc, fr, fq, lds, wid, lane); S.done(cur); }
#undef PG8_SA
#undef PG8_SB
#undef PG8_STAGE
#undef PG8_LDA
#undef PG8_LDB
#undef PG8_MMA
#undef PG8_WAIT_V
#undef PG8_WAIT_L
#undef PG8_BAR
#undef PG8_SCHED
}
}

struct EpiUp2 {
    static constexpr bool PERM = true, AFTER_DRAIN = false;
    const float* sumsq; bf16_t* U;
    DI void operator()(const pg8::f32x4 (&acc)[2][2][4][2], const pg8::Unit& u, int wr, int wc, int fr, int fq) const {
        const int row0 = u.pm * 256 + wr * 64 + fr, col0 = u.pn * 256 + wc * 32 + 8 * fq;
#pragma unroll
        for (int ai = 0; ai < 2; ++ai)
#pragma unroll
            for (int m = 0; m < 4; ++m) {
                const int row = row0 + ai * 128 + m * 16;
                bf16_t* rp = U + (size_t)row * 4096 + col0;
#pragma unroll
                for (int bj = 0; bj < 2; ++bj) {
                    float v[8];
#pragma unroll
                    for (int n = 0; n < 2; ++n)
#pragma unroll
                        for (int e = 0; e < 4; ++e) { const float t = fmaxf(acc[ai][bj][m][n][e], 0.f); v[4 * n + e] = t * t; }
                    u32x4 w; w.x = pk_bf16(v[0], v[1]); w.y = pk_bf16(v[2], v[3]); w.z = pk_bf16(v[4], v[5]); w.w = pk_bf16(v[6], v[7]);
                    *(u32x4*)(rp + bj * 128) = w;
                }
            }
    }
};

struct EpiRes2 {
    static constexpr bool PERM = true, AFTER_DRAIN = false;
    const float* resid; float* hout; bf16_t* hb; float* sumsq_next; const float* sumsq_in;
    DI void operator()(const pg8::f32x4 (&acc)[2][2][4][2], const pg8::Unit& u, int wr, int wc, int fr, int fq) const {
        const int row0 = u.pm * 256 + wr * 64 + fr, col0 = u.pn * 256 + wc * 32 + 8 * fq;
#pragma unroll
        for (int ai = 0; ai < 2; ++ai)
#pragma unroll
            for (int m = 0; m < 4; ++m) {
                const int row = row0 + ai * 128 + m * 16; float ss = 0.f;
                const float r2 = sumsq_in ? 1.0f / (sumsq_in[row] * (1.0f / 1024.0f) + EPS) : 1.0f;
#pragma unroll
                for (int bj = 0; bj < 2; ++bj) {
                    const size_t off = (size_t)row * 1024 + col0 + bj * 128;
                    f32x4 r0 = *(const f32x4*)(resid + off), r1 = *(const f32x4*)(resid + off + 4);
#pragma unroll
                    for (int e = 0; e < 4; ++e) { r0[e] += acc[ai][bj][m][0][e] * r2; r1[e] += acc[ai][bj][m][1][e] * r2; ss += r0[e] * r0[e] + r1[e] * r1[e]; }
                    *(f32x4*)(hout + off) = r0; *(f32x4*)(hout + off + 4) = r1;
                    u32x4 w; w.x = pk_bf16(r0[0], r0[1]); w.y = pk_bf16(r0[2], r0[3]); w.z = pk_bf16(r1[0], r1[1]); w.w = pk_bf16(r1[2], r1[3]);
                    if (hb) *(u32x4*)(hb + off) = w;
                }
                ss += __shfl_xor(ss, 16); ss += __shfl_xor(ss, 32);
                if (fq == 0) __hip_atomic_fetch_add(sumsq_next + row, ss, __ATOMIC_RELAXED, __HIP_MEMORY_SCOPE_AGENT);
                asm volatile("" ::: "memory");
            }
    }
};

DI void rope8(float (&v)[8], const float* __restrict__ rope, int s, int fq) {
    const f32x4 c0 = *(const f32x4*)(rope + s * 16), c1 = *(const f32x4*)(rope + s * 16 + 4), s0 = *(const f32x4*)(rope + s * 16 + 8), s1 = *(const f32x4*)(rope + s * 16 + 12);
    const float cs[8] = {c0[0], c0[1], c0[2], c0[3], c1[0], c1[1], c1[2], c1[3]}, sn[8] = {s0[0], s0[1], s0[2], s0[3], s1[0], s1[1], s1[2], s1[3]};
#pragma unroll
    for (int e = 0; e < 8; ++e) {
        const float other = __shfl_xor(v[e], 16);
        const float a = v[e] * cs[e], bq = other * sn[e];
        v[e] = (fq == 0) ? (a - bq) : ((fq == 1) ? (a + bq) : v[e]);
    }
}

struct EpiProj0b {
    static constexpr bool PERM = true, AFTER_DRAIN = false;
    const float* sumsq; bf16_t* P; bf16_t* vta; bf16_t* vtf; float* logf; const float* bfg; const float* rope;
    DI void operator()(const pg8::f32x4 (&acc)[2][2][4][2], const pg8::Unit& u, int wr, int wc, int fr, int fq) const {
        const int row0 = u.pm * 256 + wr * 64 + fr;
#pragma unroll
        for (int bj = 0; bj < 2; ++bj) {
            const int cb = u.pn * 256 + bj * 128;
            if (cb > 3072) continue;
            if (cb == 3072 && wc != 0) continue;
            const int col0 = cb + wc * 32 + 8 * fq;
            const int region = cb >> 9;
#pragma unroll
            for (int ai = 0; ai < 2; ++ai)
#pragma unroll
                for (int m = 0; m < 4; ++m) {
                    const int row = row0 + ai * 128 + m * 16;
                    const float rstd = rsqrtf(sumsq[row] * (1.0f / 1024.0f) + EPS);
                    const int s = row & (SEQ - 1), b = row >> 13;
                    float v[8];
#pragma unroll
                    for (int n = 0; n < 2; ++n)
#pragma unroll
                        for (int e = 0; e < 4; ++e) v[4 * n + e] = acc[ai][bj][m][n][e] * rstd;
                    if (cb == 3072) {
                        if (fq == 0) {
                            f32x4 o0, o1;
#pragma unroll
                            for (int e = 0; e < 4; ++e) {
                                const float x0 = v[e] + bfg[e], x1 = v[4 + e] + bfg[4 + e];
                                o0[e] = fminf(x0, 0.f) - __logf(1.0f + __expf(-fabsf(x0))); o1[e] = fminf(x1, 0.f) - __logf(1.0f + __expf(-fabsf(x1)));
                            }
                            *(f32x4*)(logf + (size_t)row * 8) = o0; *(f32x4*)(logf + (size_t)row * 8 + 4) = o1;
                        }
                    } else if (region == 2 || region == 5) {
                        const int c = col0 - region * 512;
                        bf16_t* vt = (region == 2 ? vta : vtf) + ((size_t)(b * 512 + c) * SEQ + s);
#pragma unroll
                        for (int e = 0; e < 8; ++e) vt[(size_t)e * SEQ] = to_bf16(v[e]);
                    } else {
                        if (region < 2 && (wc & 1) == 0) rope8(v, rope, s, fq);
                        const float qs = (region == 0 || region == 3) ? QSCALE : 1.0f;
                        u32x4 w; w.x = pk_bf16(v[0] * qs, v[1] * qs); w.y = pk_bf16(v[2] * qs, v[3] * qs); w.z = pk_bf16(v[4] * qs, v[5] * qs); w.w = pk_bf16(v[6] * qs, v[7] * qs);
                        *(u32x4*)(P + (size_t)row * P0_PITCH + col0) = w;
                    }
                    asm volatile("" ::: "memory");
                }
        }
    }
};

struct EpiProj1b {
    static constexpr bool PERM = true, AFTER_DRAIN = false;
    const float* sumsq; bf16_t* P; bf16_t* vt1; float* ikraw; float* iw; const float* rope;
    DI void operator()(const pg8::f32x4 (&acc)[2][2][4][2], const pg8::Unit& u, int wr, int wc, int fr, int fq) const {
        const int row0 = u.pm * 256 + wr * 64 + fr;
#pragma unroll
        for (int bj = 0; bj < 2; ++bj) {
            const int cb = u.pn * 256 + bj * 128;
            if (cb > 3584) continue;
            if (cb == 3584 && wc == 3) continue;
            const int col0 = cb + wc * 32 + 8 * fq;
#pragma unroll
            for (int ai = 0; ai < 2; ++ai)
#pragma unroll
                for (int m = 0; m < 4; ++m) {
                    const int row = row0 + ai * 128 + m * 16;
                    const float rstd = rsqrtf(sumsq[row] * (1.0f / 1024.0f) + EPS);
                    const int s = row & (SEQ - 1), b = row >> 13;
                    float v[8];
#pragma unroll
                    for (int n = 0; n < 2; ++n)
#pragma unroll
                        for (int e = 0; e < 4; ++e) v[4 * n + e] = acc[ai][bj][m][n][e] * rstd;
                    if (cb == 3584) {
                        if (wc < 2) {
                            float* d = ikraw + (size_t)row * 64 + wc * 32 + 8 * fq;
                            *(f32x4*)d = (f32x4){v[0], v[1], v[2], v[3]}; *(f32x4*)(d + 4) = (f32x4){v[4], v[5], v[6], v[7]};
                        } else if (fq == 0) {
                            const float sc = 0.044194173824159216f;
                            *(f32x4*)(iw + (size_t)row * 8) = (f32x4){v[0] * sc, v[1] * sc, v[2] * sc, v[3] * sc}; *(f32x4*)(iw + (size_t)row * 8 + 4) = (f32x4){v[4] * sc, v[5] * sc, v[6] * sc, v[7] * sc};
                        }
                    } else if (cb >= 2048 && cb < 3072) {
                        const int c = col0 - 2048;
                        bf16_t* vt = vt1 + ((size_t)(b * 1024 + c) * SEQ + s);
#pragma unroll
                        for (int e = 0; e < 8; ++e) vt[(size_t)e * SEQ] = to_bf16(v[e]);
                    } else {
                        if ((wc & 1) == 0) rope8(v, rope, s, fq);
                        const float qs = (cb < 1024) ? QSCALE : 1.0f;
                        u32x4 w; w.x = pk_bf16(v[0] * qs, v[1] * qs); w.y = pk_bf16(v[2] * qs, v[3] * qs); w.z = pk_bf16(v[4] * qs, v[5] * qs); w.w = pk_bf16(v[6] * qs, v[7] * qs);
                        *(u32x4*)(P + (size_t)row * P1_PITCH + col0) = w;
                    }
                    asm volatile("" ::: "memory");
                }
        }
    }
};

DI void phase_iknorm(const Params& p) {
    const int tid = threadIdx.x, lane = tid & 63, wid = tid >> 6;
    const float* ikraw = (const float*)(p.ws + WS_BITMASK);
    bf16_t* ikb = (bf16_t*)(p.ws + WS_IKB);
    const float* rope = (const float*)(p.ws + WS_ROPE);
    const float g = p.in[11][lane], bt = p.in[12][lane];
    for (int row = blockIdx.x * 8 + wid; row < T_TOK; row += gridDim.x * 8) {
        const float x = ikraw[(size_t)row * 64 + lane];
        const float mean = wave_sum(x) * (1.0f / 64.0f);
        const float d = x - mean;
        const float var = wave_sum(d * d) * (1.0f / 64.0f);
        float y = d * rsqrtf(var + EPS) * g + bt;
        const int s = row & (SEQ - 1);
        const float other = __shfl_xor(y, 8);
        const float cs = rope[s * 16 + (lane & 7)], sn = rope[s * 16 + 8 + (lane & 7)];
        if (lane < 8) y = y * cs - other * sn; else if (lane < 16) y = y * cs + other * sn;
        ikb[(size_t)row * 64 + lane] = to_bf16(y);
    }
}

DI void phase_scan(const Params& p, unsigned char* lds) {
    {
        const bf16_t* P = (const bf16_t*)(p.ws + WS_PBUF);
        unsigned* bnd = (unsigned*)(p.ws + WS_BND);
        for (int u = blockIdx.x; u < 256; u += gridDim.x) {
            const int bh = u >> 3, b = bh >> 3, h = bh & 7, chunk = u & 7;
            float qm = 0.f, km = 0.f;
#pragma unroll
            for (int j = 0; j < 2; ++j) {
                const int s = chunk * 1024 + j * 512 + (int)threadIdx.x;
                const bf16_t* row = P + (size_t)(b * SEQ + s) * P0_PITCH + h * 64;
                float qs = 0.f, ks = 0.f;
#pragma unroll
                for (int c = 0; c < 8; ++c) {
                    const u32x4 qv = *(const u32x4*)(row + 1536 + c * 8), kv = *(const u32x4*)(row + 2048 + c * 8);
#pragma unroll
                    for (int e = 0; e < 4; ++e) {
                        const float q0 = __uint_as_float(qv[e] << 16), q1 = __uint_as_float(qv[e] & 0xffff0000u);
                        const float k0 = __uint_as_float(kv[e] << 16), k1 = __uint_as_float(kv[e] & 0xffff0000u);
                        qs += q0 * q0 + q1 * q1; ks += k0 * k0 + k1 * k1;
                    }
                }
                qm = fmaxf(qm, qs); km = fmaxf(km, ks);
            }
#pragma unroll
            for (int d = 32; d >= 1; d >>= 1) { qm = fmaxf(qm, __shfl_xor(qm, d)); km = fmaxf(km, __shfl_xor(km, d)); }
            if ((threadIdx.x & 63) == 0) { atomicMax(bnd + bh * 2, __float_as_uint(qm)); atomicMax(bnd + bh * 2 + 1, __float_as_uint(km)); }
        }
    }
    const float* logf = (const float*)(p.ws + WS_LOGF);
    float* c2 = (float*)(p.ws + WS_C2);
    float* wsum = (float*)lds;
    const int tid = threadIdx.x, lane = tid & 63, wid = tid >> 6;
    for (int u = blockIdx.x; u < 32; u += gridDim.x) {
        const int b = u >> 3, h = u & 7;
        float v[16]; float tot = 0.f;
#pragma unroll
        for (int j = 0; j < 16; ++j) { v[j] = logf[((size_t)b * SEQ + tid * 16 + j) * 8 + h]; tot += v[j]; v[j] = tot; }
        float inc = tot;
#pragma unroll
        for (int d = 1; d < 64; d <<= 1) { const float o = __shfl_up(inc, d); if (lane >= d) inc += o; }
        if (lane == 63) wsum[wid] = inc;
        __syncthreads();
        float base = inc - tot;
        for (int w = 0; w < wid; ++w) base += wsum[w];
#pragma unroll
        for (int j = 0; j < 16; ++j) c2[((size_t)(b * 8 + h)) * SEQ + tid * 16 + j] = (base + v[j]) * LOG2E;
        __syncthreads();
    }
}

template <int MODE, int DRY = 0>
DI void attn_phase(const Params& p, unsigned char* lds) {
    constexpr int DVB = (MODE == 0) ? 4 : 2;
    constexpr int QU = (MODE == 0) ? 128 : 256;
    constexpr int NH = (MODE == 0) ? 4 : (MODE == 1 ? 8 : 16);
    constexpr int NQB = SEQ / QU, NBH = 4 * NH, NUNITS = NQB * NBH;
    constexpr int NJ = (MODE == 0) ? 4 : 2, NKJ = NJ / 2;
    constexpr int VT_OFF = (MODE == 0) ? 18432 : 9216;
    constexpr int CK_OFF = 17920;
    constexpr int STG = (MODE == 0) ? 35840 : 18432;
    constexpr int XCH_OFF = 3 * 35840;
    const int tid = threadIdx.x, lane = tid & 63, wid = tid >> 6, r32 = lane & 31, hh = lane >> 5;
    const int lrow = tid >> 3, lkc = tid & 7;
    const int G = gridDim.x;
    unsigned char* ws = p.ws;
    const bf16_t* P = (const bf16_t*)(ws + WS_PBUF);
    const bf16_t* VT = (const bf16_t*)(ws + WS_VT) + (MODE == 1 ? (size_t)4 * 512 * SEQ : 0);
    bf16_t* mixed = (bf16_t*)(ws + WS_MIXED);
    const float* c2 = (const float*)(ws + WS_C2);
    const u64* bitmask = (const u64*)(ws + WS_BITMASK);
    constexpr int PITCH = (MODE == 2) ? P1_PITCH : P0_PITCH;
    float lam = 0.f;
    if (MODE == 0) {
        float d1 = 0.f, d2 = 0.f;
        for (int i = 0; i < 64; ++i) { d1 += p.in[4][i] * p.in[5][i]; d2 += p.in[6][i] * p.in[7][i]; }
        lam = expf(d1) - expf(d2) + 0.2f;
    }
    for (int it = 0; it * G < NUNITS; ++it) {
        int qb, bh;
        if (MODE == 1 && G == 256) {
            const int p_ = (int)blockIdx.x, hbase = p_ & 7, bsel = (p_ >> 3) & 3, qgrp = p_ >> 5;
            qb = 8 * (3 - it) + qgrp; bh = bsel * 8 + ((hbase + 3 * it) & 7);
        } else {
            const int pos = (it & 1) ? (G - 1 - (int)blockIdx.x) : (int)blockIdx.x;
            const int u = it * G + pos;
            if (u >= NUNITS) continue;
            qb = NQB - 1 - u / NBH; bh = u % NBH;
        }
        const int b = bh / NH, h = bh % NH;
        const int q0 = qb * QU;
        const int cmap = (MODE == 0) ? (wid >> 2) : 0;
        const int qw0 = q0 + 32 * ((MODE == 0) ? (wid & 3) : wid);
        const int nt = (q0 + QU) >> 6;
        const int myq = qw0 + r32;
        int j0 = 0;
        if (MODE == 1) {
            const unsigned* bnd = (const unsigned*)(ws + WS_BND) + (b * 8 + h) * 2;
            const float Bnd = sqrtf(__uint_as_float(bnd[0]) * __uint_as_float(bnd[1])) * 1.02f + 0.5f;
            const float thr = -(2.0f * Bnd + 30.0f);
            const float* cc = c2 + (size_t)(b * 8 + h) * SEQ;
            const float cq0 = cc[q0];
            int lo = 0, hi = q0 >> 6;
            while (lo < hi) { const int mid = (lo + hi) >> 1; if (cq0 - cc[64 * mid + 63] >= thr) hi = mid; else lo = mid + 1; }
            j0 = lo;
        }
        const int ntl = nt - j0;
        const bf16_t* src[NJ]; size_t step[NJ];
        if (MODE == 0) {
            src[0] = P + (size_t)(b * SEQ + lrow) * PITCH + 512 + (h * 2) * 64 + lkc * 8; step[0] = (size_t)64 * PITCH;
            src[1] = src[0] + 64; step[1] = step[0];
            src[2] = VT + (size_t)(b * 512 + h * 128 + lrow) * SEQ + lkc * 8; step[2] = 64;
            src[3] = src[2] + (size_t)64 * SEQ; step[3] = 64;
        } else if (MODE == 1) {
            src[0] = P + (size_t)(b * SEQ + lrow) * PITCH + 2048 + h * 64 + lkc * 8; step[0] = (size_t)64 * PITCH;
            src[1] = VT + (size_t)(b * 512 + h * 64 + lrow) * SEQ + lkc * 8; step[1] = 64;
        } else {
            src[0] = P + (size_t)(b * SEQ + lrow) * PITCH + 1024 + h * 64 + lkc * 8; step[0] = (size_t)64 * PITCH;
            src[1] = VT + (size_t)(b * 1024 + h * 64 + lrow) * SEQ + lkc * 8; step[1] = 64;
        }
        const int qcol = (MODE == 0) ? (h * 2 + cmap) * 64 : (MODE == 1 ? 1536 + h * 64 : h * 64);
        bf16x8 qf[4];
#pragma unroll
        for (int ks = 0; ks < 4; ++ks) qf[ks] = *(const bf16x8*)(P + (size_t)(b * SEQ + myq) * PITCH + qcol + 16 * ks + 8 * hh);
        const float* ckp = nullptr;
        if (MODE == 1) ckp = c2 + (size_t)(b * 8 + h) * SEQ;
        const u64* mrow = nullptr; u64 wcur = 0, wnext = 0, wnext2 = 0;
        if (MODE == 2) { mrow = bitmask + (size_t)(b * SEQ + myq) * 128; wcur = mrow[0]; }
        f32x16 o[DVB];
#pragma unroll
        for (int db = 0; db < DVB; ++db)
#pragma unroll
            for (int i = 0; i < 16; ++i) o[db][i] = 0.f;
        float m = -1e30f, l = 0.f;
        constexpr bool DEEP = (MODE != 0);
        u32x4 rgE[NJ], rgO[NJ]; float ckrE = 0.f, ckrO = 0.f;
        auto gload = [&](u32x4 (&rg)[NJ], float& ckr, int t) {
#pragma unroll
            for (int j = 0; j < NJ; ++j) rg[j] = *(const u32x4*)(src[j] + (size_t)t * step[j]);
            if (MODE == 1 && tid < 64) ckr = ckp[t * 64 + tid];
        };
        auto lstore = [&](const u32x4 (&rg)[NJ], const float ckr, int stg) {
            unsigned char* sb = lds + stg * STG;
#pragma unroll
            for (int j = 0; j < NJ; ++j) {
                if (j < NKJ) *(u32x4*)(sb + j * 9216 + lrow * 144 + lkc * 16) = rg[j];
                else { unsigned char* d = sb + VT_OFF + (lrow + 64 * (j - NKJ)) * 136 + lkc * 16; u32x2 a, c; a.x = rg[j].x; a.y = rg[j].y; c.x = rg[j].z; c.y = rg[j].w; *(u32x2*)d = a; *(u32x2*)(d + 8) = c; }
            }
            if (MODE == 1 && tid < 64) *(float*)(sb + CK_OFF + tid * 4) = ckr;
        };
        const unsigned koff = cmap * 9216 + r32 * 144 + hh * 16;
        const unsigned voff = VT_OFF + r32 * 136 + hh * 8;
        auto qk = [&](f32x16 (&s)[2], float& mi, int stg) {
            const unsigned char* kb_ = lds + stg * STG + koff;
            const unsigned mb = pk_bf16((m > -1e29f) ? -m : 0.f, 0.f) & 0xffffu;
            mi = -__uint_as_float(mb << 16);
            u32x4 qxw; qxw.x = hh ? 0u : mb; qxw.y = 0u; qxw.z = 0u; qxw.w = 0u;
            u32x4 kxw; kxw.x = hh ? 0u : 0x3f80u; kxw.y = 0u; kxw.z = 0u; kxw.w = 0u;
            const bf16x8 qx = __builtin_bit_cast(bf16x8, qxw), kx = __builtin_bit_cast(bf16x8, kxw);
            f32x16 zero;
#pragma unroll
            for (int i = 0; i < 16; ++i) zero[i] = 0.f;
#pragma unroll
            for (int blk = 0; blk < 2; ++blk) {
                s[blk] = MFMA32(kx, qx, zero);
#pragma unroll
                for (int ks = 0; ks < 4; ++ks) {
                    const bf16x8 kf = *(const bf16x8*)(kb_ + blk * 4608 + ks * 32);
                    s[blk] = MFMA32(kf, qf[ks], s[blk]);
                }
            }
        };
        auto softmax_pv = [&](f32x16 (&s)[2], const float mi, int kt, int stg) {
            const int k0 = kt * 64;
            const unsigned char* sb = lds + stg * STG;
            if (DRY != 1) {
            if (MODE == 1) {
#pragma unroll
                for (int blk = 0; blk < 2; ++blk)
#pragma unroll
                    for (int g = 0; g < 4; ++g) {
                        const f32x4 c4 = *(const f32x4*)(sb + CK_OFF + (32 * blk + 8 * g + 4 * hh) * 4);
#pragma unroll
                        for (int e = 0; e < 4; ++e) s[blk][4 * g + e] -= c4[e];
                    }
            }
            if (MODE == 2) {
                const u64 wsh = wcur >> (4 * hh);
                const int wlo = (int)(unsigned)wsh, whi = (int)(unsigned)(wsh >> 32);
#pragma unroll
                for (int i = 0; i < 16; ++i) {
                    const int bit = (i & 3) + 8 * (i >> 2);
                    const unsigned m0 = (unsigned)__builtin_amdgcn_sbfe(wlo, bit, 1), m1 = (unsigned)__builtin_amdgcn_sbfe(whi, bit, 1);
                    s[0][i] = __uint_as_float((__float_as_uint(s[0][i]) & m0) | (0xff800000u & ~m0));
                    s[1][i] = __uint_as_float((__float_as_uint(s[1][i]) & m1) | (0xff800000u & ~m1));
                }
            } else if (k0 + 63 > qw0) {
#pragma unroll
                for (int blk = 0; blk < 2; ++blk)
#pragma unroll
                    for (int i = 0; i < 16; ++i) { const int key = k0 + 32 * blk + crow(i, hh); if (key > myq) s[blk][i] = -INFINITY; }
            }
            float mx = s[0][0];
#pragma unroll
            for (int i = 1; i < 16; ++i) mx = fmaxf(mx, s[0][i]);
#pragma unroll
            for (int i = 0; i < 16; ++i) mx = fmaxf(mx, s[1][i]);
            mx = xhalf_max(mx);
            const float mabs = mi + mx;
            const bool up = mabs > m + 8.0f;
            const float mn = up ? __uint_as_float(pk_bf16(mabs, 0.f) << 16) : m;
            const float shift = mn - mi;
            if (__ballot(shift != 0.f) != 0) {
                if (__ballot(up) != 0) {
                    const float alpha = __builtin_amdgcn_exp2f(m - mn);
                    l *= alpha;
#pragma unroll
                    for (int db = 0; db < DVB; ++db)
#pragma unroll
                        for (int i = 0; i < 16; ++i) o[db][i] *= alpha;
                    m = mn;
                }
#pragma unroll
                for (int blk = 0; blk < 2; ++blk)
#pragma unroll
                    for (int i = 0; i < 16; ++i) s[blk][i] -= shift;
            }
            float ls = 0.f;
#pragma unroll
            for (int blk = 0; blk < 2; ++blk)
#pragma unroll
                for (int i = 0; i < 16; ++i) { const float e = __builtin_amdgcn_exp2f(s[blk][i]); s[blk][i] = e; ls += e; }
            l += ls;
            }
#pragma unroll
            for (int blk = 0; blk < 2; ++blk)
#pragma unroll
                for (int sp = 0; sp < 2; ++sp) {
                    u32x4 pw;
                    pw.x = pk_bf16(s[blk][8 * sp + 0], s[blk][8 * sp + 1]); pw.y = pk_bf16(s[blk][8 * sp + 2], s[blk][8 * sp + 3]);
                    pw.z = pk_bf16(s[blk][8 * sp + 4], s[blk][8 * sp + 5]); pw.w = pk_bf16(s[blk][8 * sp + 6], s[blk][8 * sp + 7]);
                    const bf16x8 pf = __builtin_bit_cast(bf16x8, pw);
#pragma unroll
                    for (int db = 0; db < DVB; ++db) {
                        const unsigned char* va = sb + voff + db * 32 * 136 + (32 * blk + 16 * sp) * 2;
                        const u32x2 lo = *(const u32x2*)va, hi = *(const u32x2*)(va + 16);
                        u32x4 vw; vw.x = lo.x; vw.y = lo.y; vw.z = hi.x; vw.w = hi.y;
                        o[db] = MFMA32(__builtin_bit_cast(bf16x8, vw), pf, o[db]);
                    }
                }
        };
        auto stepf = [&](f32x16 (&s_cur)[2], const float mi_cur, f32x16 (&s_nxt)[2], float& mi_nxt, u32x4 (&rg_ld)[NJ], float& ck_ld, const u32x4 (&rg_st)[NJ], const float ck_st, int kk) {
            const int kt = j0 + kk;
            if (DEEP) { if (kk + 3 < ntl) gload(rg_ld, ck_ld, kt + 3); } else { if (kk + 2 < ntl) gload(rg_ld, ck_ld, kt + 2); }
            if (MODE == 2 && kk + 2 < ntl) wnext2 = mrow[kt + 2];
            if (kk + 1 < ntl && (kt + 1) * 64 <= qw0 + 31) qk(s_nxt, mi_nxt, (kk + 1) % 3);
            if (kt * 64 <= qw0 + 31) softmax_pv(s_cur, mi_cur, kt, kk % 3);
            if (MODE == 2) { wcur = wnext; wnext = wnext2; }
            if (kk + 2 < ntl) lstore(rg_st, ck_st, (kk + 2) % 3);
            __syncthreads();
        };
        gload(rgE, ckrE, j0); lstore(rgE, ckrE, 0);
        if (ntl > 1) { gload(rgE, ckrE, j0 + 1); lstore(rgE, ckrE, 1); }
        if (DEEP && ntl > 2) gload(rgO, ckrO, j0 + 2);
        if (MODE == 2 && ntl > 1) wnext = mrow[j0 + 1];
        __syncthreads();
        f32x16 sA[2], sB[2]; float miA = 0.f, miB = 0.f;
        if (j0 * 64 <= qw0 + 31) qk(sA, miA, 0);
        for (int kk = 0; kk < ntl; kk += 2) {
            if (DEEP) {
                stepf(sA, miA, sB, miB, rgE, ckrE, rgO, ckrO, kk);
                if (kk + 1 < ntl) stepf(sB, miB, sA, miA, rgO, ckrO, rgE, ckrE, kk + 1);
            } else {
                stepf(sA, miA, sB, miB, rgE, ckrE, rgE, ckrE, kk);
                if (kk + 1 < ntl) stepf(sB, miB, sA, miA, rgE, ckrE, rgE, ckrE, kk + 1);
            }
        }
        l = xhalf_sum(l);
        const float inv = 1.0f / l;
        const int tok = b * SEQ + myq;
        if (DRY != 0 && o[0][0] != 12345.678f) continue;
        if (MODE == 0) {
            float* xch = (float*)(lds + XCH_OFF);
            const int qs = wid & 3;
#pragma unroll
            for (int db = 0; db < DVB; ++db) {
                if (cmap == 1) {
#pragma unroll
                    for (int i = 0; i < 16; ++i) xch[(qs * 16 + i) * 64 + lane] = o[db][i] * inv;
                }
                __syncthreads();
                if (cmap == 0) {
#pragma unroll
                    for (int i = 0; i < 16; ++i) o[db][i] = o[db][i] * inv - lam * xch[(qs * 16 + i) * 64 + lane];
                }
                __syncthreads();
            }
            if (cmap == 0) {
                float ss = 0.f;
#pragma unroll
                for (int db = 0; db < DVB; ++db)
#pragma unroll
                    for (int i = 0; i < 16; ++i) ss += o[db][i] * o[db][i];
                ss = xhalf_sum(ss);
                const float rn = rsqrtf(ss * (1.0f / 128.0f) + EPS) * 0.8f;
                const float* subg = p.in[8];
#pragma unroll
                for (int db = 0; db < DVB; ++db)
#pragma unroll
                    for (int g = 0; g < 4; ++g) {
                        const int d0 = 32 * db + 8 * g + 4 * hh;
                        const f32x4 gg = *(const f32x4*)(subg + d0);
                        store4_bf16(mixed + (size_t)tok * 1024 + h * 128 + d0, o[db][4 * g] * rn * gg[0], o[db][4 * g + 1] * rn * gg[1], o[db][4 * g + 2] * rn * gg[2], o[db][4 * g + 3] * rn * gg[3]);
                    }
            }
        } else {
            const int cbase = (MODE == 1) ? 512 + h * 64 : h * 64;
#pragma unroll
            for (int db = 0; db < DVB; ++db)
#pragma unroll
                for (int g = 0; g < 4; ++g)
                    store4_bf16(mixed + (size_t)tok * 1024 + cbase + 32 * db + 8 * g + 4 * hh, o[db][4 * g] * inv, o[db][4 * g + 1] * inv, o[db][4 * g + 2] * inv, o[db][4 * g + 3] * inv);
        }
    }
}

DI unsigned sortable(float x) { if (x == 0.f) x = 0.f; const unsigned u = __float_as_uint(x); return (u & 0x80000000u) ? ~u : (u | 0x80000000u); }

DI void hist_select(const unsigned* hrow, int need, int lane, int& bsel, int& above, bool& hit) {
    const u32x4 w0 = *(const u32x4*)(hrow + 8 * lane), w1 = *(const u32x4*)(hrow + 8 * lane + 4);
    unsigned wv[8] = {w0.x, w0.y, w0.z, w0.w, w1.x, w1.y, w1.z, w1.w};
    int cnt[16]; int tot = 0;
#pragma unroll
    for (int j = 0; j < 8; ++j) { cnt[2 * j] = (int)(wv[j] & 0xffffu); cnt[2 * j + 1] = (int)(wv[j] >> 16); tot += cnt[2 * j] + cnt[2 * j + 1]; }
    int inc = tot;
#pragma unroll
    for (int d = 1; d < 64; d <<= 1) { const int o = __shfl_down(inc, d); if (lane + d < 64) inc += o; }
    const int exc = inc - tot;
    const bool pred = (inc >= need) && (exc < need);
    const u64 bal = __ballot(pred);
    int mybin = 0, myabove = exc; bool found = false; int run = exc;
#pragma unroll
    for (int j = 15; j >= 0; --j) { if (!found && run + cnt[j] >= need) { found = true; mybin = 16 * lane + j; myabove = run; } run += cnt[j]; }
    hit = (bal != 0);
    if (bal == 0) {
        const int total = __shfl(inc, 0), c0 = __shfl(cnt[0], 0);
        bsel = 0; above = total - c0;
    } else {
        const int L = __ffsll((long long)bal) - 1;
        bsel = __shfl(mybin, L); above = __shfl(myabove, L);
    }
}

template <int N> struct IC { static constexpr int value = N; };

DI void phase_index(const Params& p, unsigned char* lds) {
    constexpr int NUNITS = 4 * 256;
    constexpr int TILE_OFF = 65536, STAGE_B = 36864, INFO_OFF = 65536 + 2 * 36864;
    const int tid = threadIdx.x, lane = tid & 63, wid = tid >> 6, r32 = lane & 31, hh = lane >> 5;
    const int lrow = tid >> 3, lkc = tid & 7;
    const int G = gridDim.x;
    unsigned char* ws = p.ws;
    const bf16_t* P = (const bf16_t*)(ws + WS_PBUF);
    const bf16_t* ikb = (const bf16_t*)(ws + WS_IKB);
    const float* iw = (const float*)(ws + WS_IW);
    u64* bitmask = (u64*)(ws + WS_BITMASK);
    unsigned* hist = (unsigned*)lds;
    int* info = (int*)(lds + INFO_OFF);
    for (int it = 0; it * G < NUNITS; ++it) {
        const int pos = (it & 1) ? (G - 1 - (int)blockIdx.x) : (int)blockIdx.x;
        const int u = it * G + pos;
        if (u >= NUNITS) continue;
        const int qblk = 255 - (u >> 2), b = u & 3;
        const int t0 = qblk * 32;
        const int nt = (t0 >> 6) + 1;
        const int nst = (nt + 3) >> 2;
        bf16x8 qf[4];
        {
            const bf16_t* qp = P + (size_t)(b * SEQ + t0 + 4 * wid + (r32 >> 3)) * P1_PITCH + 3072 + (r32 & 7) * 64 + 8 * hh;
#pragma unroll
            for (int ks = 0; ks < 4; ++ks) qf[ks] = *(const bf16x8*)(qp + 16 * ks);
        }
        f32x4 wq[4];
#pragma unroll
        for (int q = 0; q < 4; ++q) wq[q] = *(const f32x4*)(iw + (size_t)(b * SEQ + t0 + 4 * wid + q) * 8 + 4 * hh);
        const bf16_t* srcp = ikb + (size_t)(b * SEQ + lrow) * 64 + lkc * 8;
        const unsigned st_off = TILE_OFF + lrow * 144 + lkc * 16;
        const unsigned rd_off = TILE_OFF + r32 * 144 + hh * 16;
        int b1v[2] = {0, 0}, tauv[2] = {0, 0};
        int rq[4] = {0, 0, 0, 0}, cntq[4] = {0, 0, 0, 0};
        const unsigned hbase0 = (unsigned)(4 * wid + 2 * hh) * 2048u;
        const int tq0 = t0 + 4 * wid + 2 * hh;
        u64 Gm[4], Em[4];
        int cntA[2] = {0, 0}; int hiv[2] = {0, 0}, sbv[2] = {8, 8}, kshv[2] = {12, 12};
        auto mma = [&](f32x16& s, unsigned off) {
#pragma unroll
            for (int i = 0; i < 16; ++i) s[i] = 0.f;
#pragma unroll
            for (int ks = 0; ks < 4; ++ks) { const bf16x8 kf = *(const bf16x8*)(lds + off + ks * 32); s = MFMA32(qf[ks], kf, s); }
        };
        auto proc = [&](auto PASSC, auto DIAGC, const f32x16& s, int k0, int kb) {
            constexpr int PASS = decltype(PASSC)::value; constexpr bool DIAG = decltype(DIAGC)::value != 0;
            f32x4 tot;
#pragma unroll
            for (int q = 0; q < 4; ++q) {
                float pr = 0.f;
#pragma unroll
                for (int e = 0; e < 4; ++e) pr += wq[q][e] * fmaxf(s[4 * q + e], 0.f);
                tot[q] = xhalf_sum(pr);
            }
            const int key = k0 + 32 * kb + r32;
#pragma unroll
            for (int qq = 0; qq < 2; ++qq) {
                const float t_lo = tot[qq], t_hi = tot[2 + qq];
                const float sc = ((lane & 32) ? t_hi : t_lo) + 0.0f;
                const unsigned ub = __float_as_uint(sc);
                const unsigned uk = ub ^ ((unsigned)((int)ub >> 31) | 0x80000000u);
                const bool valid = DIAG ? (key <= tq0 + qq) : true;
                if (PASS == 0) {
                    if (valid) { const unsigned a = (uk >> 21) & 0x7feu; atomicAdd((unsigned*)(lds + hbase0 + qq * 2048 + (a & ~3u)), 1u << ((a & 2u) << 3)); }
                } else if (PASS == 1) {
                    if (valid && (int)(uk >> 22) == b1v[qq]) { const unsigned a = (uk >> 11) & 0x7feu; atomicAdd((unsigned*)(lds + hbase0 + qq * 2048 + (a & ~3u)), 1u << ((a & 2u) << 3)); }
                } else if (PASS == 3) {
                    if (valid) {
                        const int k10 = (int)(uk >> 22), d = k10 - b1v[qq];
                        if (k10 > hiv[qq]) cntA[qq] += 1;
                        else if (d >= 0) {
                            const unsigned bin = ((unsigned)d << sbv[qq]) | ((uk >> (22 - sbv[qq])) & ((1u << sbv[qq]) - 1u));
                            const unsigned a = bin << 1;
                            atomicAdd((unsigned*)(lds + hbase0 + qq * 2048 + (a & ~3u)), 1u << ((a & 2u) << 3));
                        }
                    }
                } else {
                    const int k20 = (int)(uk >> kshv[qq]);
                    const u64 bg = __ballot(valid && k20 > tauv[qq]);
                    const u64 be = __ballot(valid && k20 == tauv[qq]);
                    Gm[qq] |= (bg & 0xffffffffull) << (32 * kb); Gm[2 + qq] |= (bg >> 32) << (32 * kb);
                    Em[qq] |= (be & 0xffffffffull) << (32 * kb); Em[2 + qq] |= (be >> 32) << (32 * kb);
                }
            }
        };
        auto finish_tile = [&](int kt) {
#pragma unroll
            for (int q = 0; q < 4; ++q) {
                u64 take = Em[q];
                const int neq = __popcll(take);
                if (cntq[q] + neq > rq[q]) {
                    int keep = rq[q] - cntq[q]; if (keep < 0) keep = 0;
                    while (__popcll(take) > keep) take &= ~(1ull << (63 - __clzll((long long)take)));
                }
                cntq[q] += neq;
                const u64 fin = Gm[q] | take;
                if (lane == q) bitmask[(size_t)(b * SEQ + t0 + 4 * wid + q) * 128 + kt] = fin;
            }
        };
        auto run_pass = [&](auto PASSC, const bool samp) {
            constexpr int PASS = decltype(PASSC)::value;
            if (PASS == 3) { cntA[0] = 0; cntA[1] = 0; }
            if (PASS != 2) {
#pragma unroll
                for (int j = 0; j < 8; ++j) *(u32x4*)(lds + wid * 8192 + j * 1024 + lane * 16) = (u32x4){0u, 0u, 0u, 0u};
            }
            u32x4 rg[4];
#pragma unroll
            for (int j = 0; j < 4; ++j) rg[j] = *(const u32x4*)(srcp + (size_t)(64 * j) * 64);
            __syncthreads();
#pragma unroll
            for (int j = 0; j < 4; ++j) *(u32x4*)(lds + st_off + j * 9216) = rg[j];
            __syncthreads();
            for (int st = 0; st < nst; ++st) {
                const unsigned bufo = (st & 1) * STAGE_B;
                if (st + 1 < nst) {
#pragma unroll
                    for (int j = 0; j < 4; ++j) rg[j] = *(const u32x4*)(srcp + (size_t)((st + 1) * 256 + 64 * j) * 64);
                }
                const int nsub = samp ? 1 : ((nt - 4 * st) < 4 ? (nt - 4 * st) : 4);
                f32x16 sA, sB;
                mma(sA, rd_off + bufo);
                for (int sub = 0; sub < nsub; ++sub) {
                    const int kt = 4 * st + sub, k0 = kt * 64;
                    const unsigned toff = rd_off + bufo + sub * 9216;
                    if (PASS == 2) {
#pragma unroll
                        for (int q = 0; q < 4; ++q) { Gm[q] = 0; Em[q] = 0; }
                    }
                    mma(sB, toff + 4608);
                    if (kt == nt - 1) proc(PASSC, IC<1>{}, sA, k0, 0); else proc(PASSC, IC<0>{}, sA, k0, 0);
                    if (sub + 1 < nsub) mma(sA, toff + 9216);
                    if (kt == nt - 1) proc(PASSC, IC<1>{}, sB, k0, 1); else proc(PASSC, IC<0>{}, sB, k0, 1);
                    if (PASS == 2) finish_tile(kt);
                }
                if (st + 1 < nst) {
#pragma unroll
                    for (int j = 0; j < 4; ++j) *(u32x4*)(lds + st_off + (STAGE_B - bufo) + j * 9216) = rg[j];
                }
                __syncthreads();
            }
            if (PASS != 2) {
                int ca0 = cntA[0], ca1 = cntA[1];
                if (PASS == 3) {
#pragma unroll
                    for (int d = 1; d < 32; d <<= 1) { ca0 += __shfl_xor(ca0, d); ca1 += __shfl_xor(ca1, d); }
                }
#pragma unroll
                for (int q = 0; q < 4; ++q) {
                    const int ql = 4 * wid + q;
                    int need = 256;
                    if (PASS == 0) need = samp ? 64 : 256;
                    else if (PASS == 1) need = info[ql * 4 + 1];
                    else need = 256 - __shfl((q & 1) ? ca1 : ca0, 32 * (q >> 1));
                    int bsel, above; bool hit;
                    if (PASS == 0 && samp) {
                        int bhi, blo, ab2; bool h2;
                        hist_select(hist + ql * 512, 32, lane, bhi, above, hit);
                        hist_select(hist + ql * 512, 128, lane, blo, ab2, h2);
                        if (!h2) blo = 0;
                        const int nb = bhi - blo + 1;
                        int sb = 8; while (sb > 0 && (nb << sb) > 1024) --sb;
                        if (lane == 0) { info[ql * 4 + 0] = blo; info[ql * 4 + 1] = bhi; info[160 + ql] = sb; if ((nb << sb) > 1024) info[128] = 1; }
                    } else {
                    hist_select(hist + ql * 512, need > 0 ? need : 1, lane, bsel, above, hit);
                    if (lane == 0) {
                        if (PASS == 0) { info[ql * 4 + 0] = bsel; info[ql * 4 + 1] = need - above; }
                        else if (PASS == 1) { info[ql * 4 + 2] = (info[ql * 4 + 0] << 10) | bsel; info[ql * 4 + 3] = need - above; info[160 + ql] = 10; }
                        else {
                            if (need <= 0 || !hit) info[128] = 1;
                            const int sb = info[160 + ql];
                            info[ql * 4 + 2] = ((info[ql * 4 + 0] + (bsel >> sb)) << sb) | (bsel & ((1 << sb) - 1)); info[ql * 4 + 3] = need - above;
                        }
                    }
                    }
                }
                __syncthreads();
#pragma unroll
                for (int qq = 0; qq < 2; ++qq) { const int ql = 4 * wid + 2 * hh + qq; b1v[qq] = info[ql * 4 + 0]; hiv[qq] = info[ql * 4 + 1]; tauv[qq] = info[ql * 4 + 2]; sbv[qq] = info[160 + ql]; kshv[qq] = 22 - sbv[qq]; }
#pragma unroll
                for (int q = 0; q < 4; ++q) { rq[q] = info[(4 * wid + q) * 4 + 3]; cntq[q] = 0; }
            }
        };
        bool have = false;
        if (nt >= 16) {
            if (tid == 0) info[128] = 0;
            run_pass(IC<0>{}, true);
            run_pass(IC<3>{}, false);
            if (info[128] == 0) have = true;
        }
        if (!have) { run_pass(IC<0>{}, false); run_pass(IC<1>{}, false); }
        run_pass(IC<2>{}, false);
        __syncthreads();
    }
}

DI void phase_final(const Params& p) {
    const int tid = threadIdx.x, lane = tid & 63, wid = tid >> 6;
    const float* sumsq = (const float*)(p.ws + WS_SUMSQ) + 4 * T_TOK;
    const float* g = p.in[17];
    float* out = p.out;
    f32x4 gg[4];
#pragma unroll
    for (int j = 0; j < 4; ++j) gg[j] = *(const f32x4*)(g + 4 * lane + 256 * j);
    for (int r0 = (blockIdx.x * 8 + wid) * 4; r0 < T_TOK; r0 += gridDim.x * 8 * 4) {
        f32x4 xv[4][4];
#pragma unroll
        for (int rr = 0; rr < 4; ++rr)
#pragma unroll
            for (int j = 0; j < 4; ++j) xv[rr][j] = *(const f32x4*)(out + (size_t)(r0 + rr) * 1024 + 4 * lane + 256 * j);
#pragma unroll
        for (int rr = 0; rr < 4; ++rr) {
            const float rstd = rsqrtf(sumsq[r0 + rr] * (1.0f / 1024.0f) + EPS);
#pragma unroll
            for (int j = 0; j < 4; ++j) {
                f32x4 v = xv[rr][j];
#pragma unroll
                for (int e = 0; e < 4; ++e) v[e] = v[e] * rstd * gg[j][e];
                *(f32x4*)(out + (size_t)(r0 + rr) * 1024 + 4 * lane + 256 * j) = v;
            }
        }
    }
}

DI void gbar(unsigned* ctr, unsigned& gen, unsigned G) {
    asm volatile("s_waitcnt vmcnt(0)" ::: "memory");
    __syncthreads();
    gen += 1;
    if (threadIdx.x == 0) {
        __builtin_amdgcn_fence(__ATOMIC_RELEASE, "agent");
        asm volatile("s_waitcnt vmcnt(0)" ::: "memory");
        __hip_atomic_fetch_add(ctr, 1u, __ATOMIC_RELAXED, __HIP_MEMORY_SCOPE_AGENT);
        while (__hip_atomic_load(ctr, __ATOMIC_RELAXED, __HIP_MEMORY_SCOPE_AGENT) < gen * G) __builtin_amdgcn_s_sleep(2);
        __builtin_amdgcn_fence(__ATOMIC_ACQUIRE, "agent");
        asm volatile("s_waitcnt vmcnt(0)" ::: "memory");
    }
    __syncthreads();
}

__global__ void __launch_bounds__(NTHREADS) fwd_megakernel(Params p) {
    extern __shared__ __attribute__((aligned(16))) unsigned char lds[];
    cg::grid_group grid = cg::this_grid();
    unsigned char* ws = p.ws;
    float* sumsq = (float*)(ws + WS_SUMSQ);
    bf16_t* hb = (bf16_t*)(ws + WS_HB);
    bf16_t* pbuf = (bf16_t*)(ws + WS_PBUF);
    bf16_t* vt = (bf16_t*)(ws + WS_VT);
    bf16_t* mixed = (bf16_t*)(ws + WS_MIXED);
    bf16_t* U = (bf16_t*)(ws + WS_PBUF);
    const float* rope = (const float*)(ws + WS_ROPE);
#define PH(k) if (p.ph_lo <= (k) && (k) < p.ph_hi)
    unsigned bgen = 0; unsigned* bctr = (unsigned*)(ws + WS_BAR);
#define SYNC(k) if (p.ph_lo <= (k) && (k) + 1 < p.ph_hi) { if ((k) == 0) grid.sync(); else gbar(bctr, bgen, gridDim.x); }
#define GEMM(EPI, e, A_, W_, N_, K_) { pg8::Gemm g{A_, W_, T_TOK, N_, K_}; pg8::StaticOrder S; S.init(T_TOK, N_, (int)gridDim.x, (int)blockIdx.x); \
        pg8::gemm_phase<EPI, pg8::StaticOrder, true, true>(l3, g, S, e); }
    PG8_LAS unsigned char* l3 = (PG8_LAS unsigned char*)lds;
    PH(0) phase_prep(p, lds);
    if (REP_PH == 0) PH(0) phase_prep(p, lds);
    SYNC(0)
    PH(1) { EpiProj0b e{sumsq, pbuf, vt, vt + (size_t)4 * 512 * SEQ, (float*)(ws + WS_LOGF), p.in[3], rope}; GEMM(EpiProj0b, e, hb, (const bf16_t*)(ws + WS_WT_IN0), 3072, 1024) }
    if (REP_PH == 1) PH(1) { EpiProj0b e{sumsq, pbuf, vt, vt + (size_t)4 * 512 * SEQ, (float*)(ws + WS_LOGF), p.in[3], rope}; GEMM(EpiProj0b, e, hb, (const bf16_t*)(ws + WS_WT_IN0), 3072, 1024) }
    SYNC(1)
    PH(2) phase_scan(p, lds);
    if (REP_PH == 2) PH(2) phase_scan(p, lds);
    SYNC(2)
    PH(3) { attn_phase<0>(p, lds); attn_phase<1>(p, lds); }
    if (REP_PH == 3) PH(3) { attn_phase<0>(p, lds); attn_phase<1>(p, lds); }
    SYNC(3)
    PH(4) { EpiRes2 e{p.in[0], p.out, hb, sumsq + T_TOK, nullptr}; GEMM(EpiRes2, e, mixed, (const bf16_t*)(ws + WS_WT_OUT0), 1024, 1024) }
    SYNC(4)
    PH(5) { EpiUp2 e{sumsq + T_TOK, U}; GEMM(EpiUp2, e, hb, (const bf16_t*)(ws + WS_WT_UP0), 4096, 1024) }
    if (REP_PH == 5) PH(5) { EpiUp2 e{sumsq + T_TOK, U}; GEMM(EpiUp2, e, hb, (const bf16_t*)(ws + WS_WT_UP0), 4096, 1024) }
    SYNC(5)
    PH(6) { EpiRes2 e{p.out, p.out, hb, sumsq + 2 * T_TOK, sumsq + T_TOK}; GEMM(EpiRes2, e, U, (const bf16_t*)(ws + WS_WT_DN0), 1024, 4096) }
    SYNC(6)
    PH(7) { EpiProj1b e{sumsq + 2 * T_TOK, pbuf, vt, (float*)(ws + WS_BITMASK), (float*)(ws + WS_IW), rope}; GEMM(EpiProj1b, e, hb, (const bf16_t*)(ws + WS_WT_IN1), 3840, 1024) }
    if (REP_PH == 7) PH(7) { EpiProj1b e{sumsq + 2 * T_TOK, pbuf, vt, (float*)(ws + WS_BITMASK), (float*)(ws + WS_IW), rope}; GEMM(EpiProj1b, e, hb, (const bf16_t*)(ws + WS_WT_IN1), 3840, 1024) }
    SYNC(7)
    PH(8) phase_iknorm(p);
    if (REP_PH == 200) { for (int i_ = 0; i_ < 10; ++i_) grid.sync(); }
    SYNC(8)
    PH(9) phase_index(p, lds);
    if (REP_PH == 9) PH(9) phase_index(p, lds);
    SYNC(9)
    if (REP_PH == 110) PH(10) attn_phase<2, 1>(p, lds);
    PH(10) attn_phase<2>(p, lds);
    if (REP_PH == 10) PH(10) attn_phase<2>(p, lds);
    SYNC(10)
    PH(11) { EpiRes2 e{p.out, p.out, hb, sumsq + 3 * T_TOK, nullptr}; GEMM(EpiRes2, e, mixed, (const bf16_t*)(ws + WS_WT_OUT1), 1024, 1024) }
    SYNC(11)
    PH(12) { EpiUp2 e{sumsq + 3 * T_TOK, U}; GEMM(EpiUp2, e, hb, (const bf16_t*)(ws + WS_WT_UP1), 4096, 1024) }
    SYNC(12)
    PH(13) { EpiRes2 e{p.out, p.out, nullptr, sumsq + 4 * T_TOK, sumsq + 3 * T_TOK}; GEMM(EpiRes2, e, U, (const bf16_t*)(ws + WS_WT_DN1), 1024, 4096) }
    SYNC(13)
    PH(14) phase_final(p);
}

extern "C" void kernel_launch(void* const* d_in, const int* in_sizes, int n_in, void* d_out, int out_size, void* d_ws, size_t ws_size, hipStream_t stream) {
    static int grid_blocks = 0;
    if (grid_blocks == 0) {
        if (n_in != 18 || ws_size < WS_END) { fprintf(stderr, "kernel_launch: unexpected n_in %d / ws_size %zu (need %zu)\n", n_in, ws_size, (size_t)WS_END); grid_blocks = -1; return; }
        int dev = 0, cus = 0, per_cu = 0;
        hipGetDevice(&dev);
        hipDeviceGetAttribute(&cus, hipDeviceAttributeMultiprocessorCount, dev);
        hipFuncSetAttribute((const void*)fwd_megakernel, hipFuncAttributeMaxDynamicSharedMemorySize, LDS_BYTES);
        hipOccupancyMaxActiveBlocksPerMultiprocessor(&per_cu, (const void*)fwd_megakernel, NTHREADS, LDS_BYTES);
        if (per_cu < 1) { fprintf(stderr, "kernel_launch: occupancy query says %d blocks/CU\n", per_cu); per_cu = 1; }
        (void)hipGetLastError();
        grid_blocks = cus;
    }
    if (grid_blocks < 0) return;
    Params p{};
    for (int i = 0; i < 18; ++i) p.in[i] = (const float*)d_in[i];
    p.out = (float*)d_out; p.ws = (unsigned char*)d_ws;
    for (int i = 0; i < 8; ++i) p.inv_freq[i] = (float)pow(500000.0, -(2.0 * i) / 16.0);
    p.ph_lo = 0; p.ph_hi = 15;
    void* args[] = {&p};
    hipError_t e = hipLaunchCooperativeKernel((const void*)fwd_megakernel, dim3(grid_blocks), dim3(NTHREADS), args, LDS_BYTES, stream);
    if (e != hipSuccess) fprintf(stderr, "cooperative launch failed: %s (grid %d)\n", hipGetErrorString(e), grid_blocks);
}
```

```cpp
#include <hip/hip_runtime.h>
#include <hip/hip_cooperative_groups.h>
#include <cstdint>
#include <cstdio>
#include <cmath>
namespace cg = cooperative_groups;

typedef unsigned short bf16_t;
typedef short bf16x8 __attribute__((ext_vector_type(8)));
typedef short s16x4 __attribute__((ext_vector_type(4)));
typedef float f32x16 __attribute__((ext_vector_type(16)));
typedef float f32x4 __attribute__((ext_vector_type(4)));
typedef float f32x2 __attribute__((ext_vector_type(2)));
typedef unsigned u32x4 __attribute__((ext_vector_type(4)));
typedef unsigned u32x2 __attribute__((ext_vector_type(2)));
typedef __bf16 bf2_t __attribute__((ext_vector_type(2)));
typedef unsigned long long u64;

#define DI __device__ __forceinline__
#define MFMA32(a, b, c) __builtin_amdgcn_mfma_f32_32x32x16_bf16((a), (b), (c), 0, 0, 0)

constexpr int T_TOK = 32768, SEQ = 8192, DM = 1024, NTHREADS = 512;
constexpr float EPS = 1e-6f;
constexpr float QSCALE = 0.125f * 1.4426950408889634f;
constexpr float LOG2E = 1.4426950408889634f;
constexpr int P0_PITCH = 3072, P1_PITCH = 3584;

constexpr size_t WS_WT_IN0 = 0;
constexpr size_t WS_WT_OUT0 = WS_WT_IN0 + (size_t)3328 * 1024 * 2;
constexpr size_t WS_WT_IN1 = WS_WT_OUT0 + (size_t)1024 * 1024 * 2;
constexpr size_t WS_WT_OUT1 = WS_WT_IN1 + (size_t)3840 * 1024 * 2;
constexpr size_t WS_WT_UP0 = WS_WT_OUT1 + (size_t)1024 * 1024 * 2;
constexpr size_t WS_WT_UP1 = WS_WT_UP0 + (size_t)4096 * 1024 * 2;
constexpr size_t WS_WT_DN0 = WS_WT_UP1 + (size_t)4096 * 1024 * 2;
constexpr size_t WS_WT_DN1 = WS_WT_DN0 + (size_t)4096 * 1024 * 2;
constexpr size_t WS_HB = WS_WT_DN1 + (size_t)4096 * 1024 * 2;
constexpr size_t WS_PBUF = WS_HB + (size_t)T_TOK * 1024 * 2;
constexpr size_t WS_VT = WS_PBUF + (size_t)T_TOK * 3584 * 2;
constexpr size_t WS_MIXED = WS_VT + (size_t)T_TOK * 1024 * 2;
constexpr size_t WS_BITMASK = WS_MIXED + (size_t)T_TOK * 1024 * 2;
constexpr size_t WS_IKB = WS_BITMASK + (size_t)T_TOK * 128 * 8;
constexpr size_t WS_IW = WS_IKB + (size_t)T_TOK * 64 * 2;
constexpr size_t WS_LOGF = WS_IW + (size_t)T_TOK * 8 * 4;
constexpr size_t WS_C2 = WS_LOGF + (size_t)T_TOK * 8 * 4;
constexpr size_t WS_SUMSQ = WS_C2 + (size_t)T_TOK * 8 * 4;
constexpr size_t WS_ROPE = WS_SUMSQ + (size_t)5 * T_TOK * 4;
constexpr size_t WS_BND = WS_ROPE + (size_t)SEQ * 16 * 4;
constexpr size_t WS_BAR = WS_BND + 256;
constexpr size_t WS_END = WS_BAR + 256;
static_assert(WS_END <= (size_t)536870912, "workspace too large");
static_assert((size_t)T_TOK * 4096 * 2 <= WS_MIXED - WS_PBUF, "U overlay too large");

constexpr int LDS_BYTES = 140288;
constexpr int REP_PH = -1;

struct Params {
    const float* in[18];
    float* out;
    unsigned char* ws;
    float inv_freq[8];
    int ph_lo, ph_hi;
};

DI unsigned pk_bf16(float a, float b) { f32x2 v = {a, b}; bf2_t r = __builtin_convertvector(v, bf2_t); return __builtin_bit_cast(unsigned, r); }
DI bf16_t to_bf16(float a) { return (bf16_t)(pk_bf16(a, 0.f) & 0xffffu); }
DI void store4_bf16(bf16_t* p, float a, float b, float c, float d) { u32x2 w; w.x = pk_bf16(a, b); w.y = pk_bf16(c, d); *(u32x2*)p = w; }
DI int crow(int i, int hh) { return (i & 3) + 8 * (i >> 2) + 4 * hh; }
DI float xhalf_sum(float v) { const auto r = __builtin_amdgcn_permlane32_swap(__float_as_uint(v), __float_as_uint(v), false, false); return __uint_as_float(r[0]) + __uint_as_float(r[1]); }
DI float xhalf_max(float v) { const auto r = __builtin_amdgcn_permlane32_swap(__float_as_uint(v), __float_as_uint(v), false, false); return fmaxf(__uint_as_float(r[0]), __uint_as_float(r[1])); }
DI float wave_sum(float v) {
#pragma unroll
    for (int d = 32; d >= 1; d >>= 1) v += __shfl_xor(v, d);
    return v;
}

struct TJob { const float* W; int K, N; const float* gain; bf16_t* dst; int k0, n0; };

DI TJob tjob_decode(const Params& p, int t) {
    unsigned char* ws = p.ws;
    TJob j; int Npad; int tt = t;
    if (tt < 384) { j.W = p.in[2]; j.K = 1024; j.N = 3080; Npad = 3072; j.gain = p.in[1]; j.dst = (bf16_t*)(ws + WS_WT_IN0); }
    else if ((tt -= 384) < 128) { j.W = p.in[9]; j.K = 1024; j.N = 1024; Npad = 1024; j.gain = nullptr; j.dst = (bf16_t*)(ws + WS_WT_OUT0); }
    else if ((tt -= 128) < 480) { j.W = p.in[10]; j.K = 1024; j.N = 3656; Npad = 3840; j.gain = p.in[1] + 1024; j.dst = (bf16_t*)(ws + WS_WT_IN1); }
    else if ((tt -= 480) < 128) { j.W = p.in[13]; j.K = 1024; j.N = 1024; Npad = 1024; j.gain = nullptr; j.dst = (bf16_t*)(ws + WS_WT_OUT1); }
    else if ((tt -= 128) < 512) { j.W = p.in[15]; j.K = 1024; j.N = 4096; Npad = 4096; j.gain = p.in[14]; j.dst = (bf16_t*)(ws + WS_WT_UP0); }
    else if ((tt -= 512) < 512) { j.W = p.in[15] + (size_t)1024 * 4096; j.K = 1024; j.N = 4096; Npad = 4096; j.gain = p.in[14] + 1024; j.dst = (bf16_t*)(ws + WS_WT_UP1); }
    else if ((tt -= 512) < 512) { j.W = p.in[16]; j.K = 4096; j.N = 1024; Npad = 1024; j.gain = nullptr; j.dst = (bf16_t*)(ws + WS_WT_DN0); }
    else { tt -= 512; j.W = p.in[16] + (size_t)4096 * 1024; j.K = 4096; j.N = 1024; Npad = 1024; j.gain = nullptr; j.dst = (bf16_t*)(ws + WS_WT_DN1); }
    const int ntn = Npad >> 7;
    j.k0 = (tt / ntn) * 64; j.n0 = (tt % ntn) * 128;
    return j;
}

DI void tjob_load(const TJob& j, float (&v)[16]) {
    const int tid = threadIdx.x;
#pragma unroll
    for (int i = 0; i < 16; ++i) {
        const int idx = tid + 512 * i, kk = idx >> 7, nn = idx & 127;
        v[i] = (j.n0 + nn < j.N) ? j.W[(size_t)(j.k0 + kk) * j.N + j.n0 + nn] : 0.f;
    }
    if (j.gain) {
#pragma unroll
        for (int i = 0; i < 16; ++i) v[i] *= j.gain[j.k0 + ((tid + 512 * i) >> 7)];
    }
}

DI void phase_prep(const Params& p, unsigned char* lds) {
    float* ldsf = (float*)lds;
    unsigned char* ws = p.ws;
    {
        const int tid = threadIdx.x;
        int t = blockIdx.x;
        float v[16];
        TJob cur{};
        if (t < 3168) { cur = tjob_decode(p, t); tjob_load(cur, v); }
        while (t < 3168) {
#pragma unroll
            for (int i = 0; i < 16; ++i) { const int idx = tid + 512 * i, kk = idx >> 7, nn = idx & 127; ldsf[nn * 65 + kk] = v[i]; }
            __syncthreads();
            const int tn = t + (int)gridDim.x;
            TJob nxt = cur;
            if (tn < 3168) { nxt = tjob_decode(p, tn); tjob_load(nxt, v); }
#pragma unroll
            for (int i = 0; i < 8; ++i) {
                const int idx = tid + 512 * i, nn = idx >> 5, kp = (idx & 31) * 2;
                *(unsigned*)(cur.dst + (size_t)(cur.n0 + nn) * cur.K + cur.k0 + kp) = pk_bf16(ldsf[nn * 65 + kp], ldsf[nn * 65 + kp + 1]);
            }
            __syncthreads();
            cur = nxt; t = tn;
        }
    }
    const int tid = threadIdx.x, lane = tid & 63, wid = tid >> 6;
    const float* x = p.in[0];
    bf16_t* hb = (bf16_t*)(ws + WS_HB);
    float* sumsq = (float*)(ws + WS_SUMSQ);
    for (int r0 = (blockIdx.x * 8 + wid) * 4; r0 < T_TOK; r0 += gridDim.x * 8 * 4) {
        f32x4 xv[4][4];
#pragma unroll
        for (int rr = 0; rr < 4; ++rr)
#pragma unroll
            for (int j = 0; j < 4; ++j) xv[rr][j] = *(const f32x4*)(x + (size_t)(r0 + rr) * 1024 + 4 * lane + 256 * j);
        float ssr[4];
#pragma unroll
        for (int rr = 0; rr < 4; ++rr) {
            const int row = r0 + rr; float ss = 0.f;
#pragma unroll
            for (int j = 0; j < 4; ++j) {
                const f32x4 v = xv[rr][j];
                ss += v[0] * v[0] + v[1] * v[1] + v[2] * v[2] + v[3] * v[3];
                store4_bf16(hb + (size_t)row * 1024 + 4 * lane + 256 * j, v[0], v[1], v[2], v[3]);
            }
            ss = wave_sum(ss); ssr[rr] = ss;
            if (lane == 0) { sumsq[row] = ss; sumsq[T_TOK + row] = 0.f; sumsq[2 * T_TOK + row] = 0.f; sumsq[3 * T_TOK + row] = 0.f; sumsq[4 * T_TOK + row] = 0.f; }
        }
        float a[32];
#pragma unroll
        for (int i = 0; i < 32; ++i) a[i] = 0.f;
        const float* Wl = p.in[2] + 3072; const float* gmix = p.in[1];
#pragma unroll
        for (int j = 0; j < 4; ++j) {
            const f32x4 g4 = *(const f32x4*)(gmix + 4 * lane + 256 * j);
#pragma unroll
            for (int e = 0; e < 4; ++e) {
                const size_t k = (size_t)(4 * lane + 256 * j + e);
                const f32x4 w0 = *(const f32x4*)(Wl + k * 3080), w1 = *(const f32x4*)(Wl + k * 3080 + 4);
#pragma unroll
                for (int rr = 0; rr < 4; ++rr) {
                    const float xk = xv[rr][j][e] * g4[e];
#pragma unroll
                    for (int c = 0; c < 4; ++c) { a[rr * 8 + c] += xk * w0[c]; a[rr * 8 + 4 + c] += xk * w1[c]; }
                }
            }
        }
        float b16[16], b8[8], b4[4], b2[2];
        { const bool bt = (lane & 32) != 0;
#pragma unroll
          for (int i = 0; i < 16; ++i) { const float snd = bt ? a[i] : a[i + 16], kp = bt ? a[i + 16] : a[i]; b16[i] = kp + __shfl_xor(snd, 32); } }
        { const bool bt = (lane & 16) != 0;
#pragma unroll
          for (int i = 0; i < 8; ++i) { const float snd = bt ? b16[i] : b16[i + 8], kp = bt ? b16[i + 8] : b16[i]; b8[i] = kp + __shfl_xor(snd, 16); } }
        { const bool bt = (lane & 8) != 0;
#pragma unroll
          for (int i = 0; i < 4; ++i) { const float snd = bt ? b8[i] : b8[i + 4], kp = bt ? b8[i + 4] : b8[i]; b4[i] = kp + __shfl_xor(snd, 8); } }
        { const bool bt = (lane & 4) != 0;
#pragma unroll
          for (int i = 0; i < 2; ++i) { const float snd = bt ? b4[i] : b4[i + 2], kp = bt ? b4[i + 2] : b4[i]; b2[i] = kp + __shfl_xor(snd, 4); } }
        float tot;
        { const bool bt = (lane & 2) != 0; const float snd = bt ? b2[0] : b2[1], kp = bt ? b2[1] : b2[0]; tot = kp + __shfl_xor(snd, 2); }
        tot += __shfl_xor(tot, 1);
        {
            const int rr = lane >> 4, c = (lane >> 1) & 7;
            const float ssm = (rr == 0) ? ssr[0] : ((rr == 1) ? ssr[1] : ((rr == 2) ? ssr[2] : ssr[3]));
            const float v = tot * rsqrtf(ssm * (1.0f / 1024.0f) + EPS) + p.in[3][c];
            if ((lane & 1) == 0) ((float*)(ws + WS_LOGF))[(size_t)(r0 + rr) * 8 + c] = fminf(v, 0.f) - __logf(1.0f + __expf(-fabsf(v)));
        }
    }
    if (blockIdx.x == 0 && threadIdx.x < 64) { ((unsigned*)(ws + WS_BND))[threadIdx.x] = 0u; ((unsigned*)(ws + WS_BAR))[threadIdx.x] = 0u; }
    float* rope = (float*)(ws + WS_ROPE);
    for (int e = blockIdx.x * NTHREADS + tid; e < SEQ * 8; e += gridDim.x * NTHREADS) {
        const int s = e >> 3, i = e & 7;
        const float ang = (float)s * p.inv_freq[i];
        const double a = (double)ang; const double k = rint(a * 0.15915494309189535); const double r = a - k * 6.283185307179586;
        const float rf = (float)r;
        rope[s * 16 + i] = __cosf(rf); rope[s * 16 + 8 + i] = __sinf(rf);
    }
}

namespace pg8 {
#define PG8_LAS __attribute__((address_space(3)))
typedef unsigned short bf16_t;
typedef short bf16x8 __attribute__((ext_vector_type(8)));
typedef float f32x4 __attribute__((ext_vector_type(4)));
typedef unsigned u32x4 __attribute__((ext_vector_type(4)));
constexpr int BM = 256, BK = 64, HALF = 128, HTB = HALF * BK * 2  , STAGE_BYTES = 8 * HTB, NXCD = 8, WGM = 8;

__host__ __device__ __forceinline__ int lds_byte(int r, int c) { const int st = (r >> 4) * 2 + (c >> 5), rr = r & 15, cc = c & 31, ob = rr * 64 + cc * 2; return st * 1024 + (ob ^ (((ob >> 9) & 1) << 5)); }
__host__ __device__ __forceinline__ void stage_rc(int b, int& R, int& C) { const int st = b / 1024, sb = b % 1024, swz = sb ^ (((sb >> 9) & 1) << 5); R = (st >> 1) * 16 + swz / 64; C = (st & 1) * 32 + (swz % 64) / 2; }
__host__ __device__ __forceinline__ int perm32(int rho) { const int n = rho >> 4, i = rho & 15; return 8 * (i >> 2) + 4 * n + (i & 3); }

struct Unit { int pm, pn; };
struct Gemm { const bf16_t* A; const bf16_t* Bt; int M, N, K; };

struct StaticOrder {
    int nM, nN, nwg, G, c;
    __host__ __device__ void init(int M, int N, int G_, int c_) { nM = M / BM; nN = N / BM; nwg = nM * nN; G = G_; c = c_; }
    __host__ __device__ bool next(int i, Unit& u) const {
        const long L = (long)i * G + c; if (L >= nwg) return false;
        int wgid = (int)L; { const int q = nwg / NXCD, r = nwg % NXCD, xcd = wgid % NXCD, off = wgid / NXCD; wgid = (xcd < r ? xcd * (q + 1) : r * (q + 1) + (xcd - r) * q) + off; }
        const int nig = WGM * nN, gid = wgid / nig, fm = gid * WGM, gsz = (nM - fm) < WGM ? (nM - fm) : WGM;
        u.pm = fm + ((wgid % nig) % gsz); u.pn = (wgid % nig) / gsz; return true;
    }
    __device__ __forceinline__ void a_ready(const Unit&) const {}
    __device__ __forceinline__ void done(const Unit&) const {}
};
__device__ __forceinline__ unsigned cvt_pk_bf16(float lo, float hi) { unsigned r; asm volatile("v_cvt_pk_bf16_f32 %0, %1, %2" : "=v"(r) : "v"(lo), "v"(hi)); return r; }
typedef float f32x2 __attribute__((ext_vector_type(2)));
template <class Epi, class Sched, bool ALIGN_EPI = false, bool SP2 = false>
__device__ __forceinline__ void gemm_phase(PG8_LAS unsigned char* lds, const Gemm g, const Sched& S, const Epi& E) {
    const int tid = threadIdx.x, wid = __builtin_amdgcn_readfirstlane(tid >> 6), lane = tid & 63, wr = wid >> 2, wc = wid & 3, fr = lane & 15, fq = lane >> 4;
    const int K = g.K, nt = K / BK;
    unsigned voffA[2], voffB[2];
#pragma unroll
    for (int i = 0; i < 2; ++i) { int R, C; stage_rc(tid * 16 + i * 8192, R, C); const int Rb = Epi::PERM ? ((R & ~31) + perm32(R & 31)) : R;
        voffA[i] = (unsigned)(R * K + C) * 2u; voffB[i] = (unsigned)(Rb * K + C) * 2u; }
    const size_t kstep = (size_t)(BK * 2);
    const size_t hstep = (size_t)HALF * K * 2;
    const size_t tstep = 2 * hstep;
    const unsigned ldsw = (unsigned)wid * 1024u;
    const int aoff = lds_byte(wr * 64 + fr, fq * 8), boff = lds_byte(wc * 32 + fr, fq * 8);
#define PG8_SA(b, h) (((b) * 2 + (h)) * HTB)
#define PG8_SB(b, h) ((4 + (b) * 2 + (h)) * HTB)
#define PG8_STAGE(bufoff, gbase, voff) do { _Pragma("unroll") for (int _i = 0; _i < 2; ++_i) \
        __builtin_amdgcn_global_load_lds((const unsigned*)((const char*)(gbase) + (voff)[_i]), (PG8_LAS unsigned*)(lds + (bufoff) + ldsw + _i * 8192), 16, 0, 0); } while (0)
#define PG8_LDA(dst, b, h) do { _Pragma("unroll") for (int m = 0; m < 4; ++m) _Pragma("unroll") for (int k = 0; k < 2; ++k) dst[m][k] = *(const PG8_LAS bf16x8*)(lds + PG8_SA(b, h) + aoff + m * 2048 + k * 1024); } while (0)
#define PG8_LDB(dst, b, h) do { _Pragma("unroll") for (int n = 0; n < 2; ++n) _Pragma("unroll") for (int k = 0; k < 2; ++k) dst[n][k] = *(const PG8_LAS bf16x8*)(lds + PG8_SB(b, h) + boff + n * 2048 + k * 1024); } while (0)
#define PG8_MMA(ai, bj, At, Bt) do { __builtin_amdgcn_s_setprio(1); _Pragma("unroll") for (int m = 0; m < 4; ++m) _Pragma("unroll") for (int n = 0; n < 2; ++n) _Pragma("unroll") for (int k = 0; k < 2; ++k) \
        acc[ai][bj][m][n] = __builtin_amdgcn_mfma_f32_16x16x32_bf16(Bt[n][k], At[m][k], acc[ai][bj][m][n], 0, 0, 0); __builtin_amdgcn_s_setprio(0); } while (0)
#define PG8_WAIT_V(n) asm volatile("s_waitcnt vmcnt(" #n ")" ::: "memory")
#define PG8_WAIT_L(n) asm volatile("s_waitcnt lgkmcnt(" #n ")" ::: "memory")
#define PG8_BAR __builtin_amdgcn_s_barrier()
#define PG8_SCHED __builtin_amdgcn_sched_barrier(0)
    Unit cur, nxt; int ui = 0;
    if (!S.next(0, cur)) return;
    f32x4 acc[2][2][4][2];
#pragma unroll
    for (int a = 0; a < 2; ++a)
#pragma unroll
        for (int b = 0; b < 2; ++b)
#pragma unroll
            for (int m = 0; m < 4; ++m)
#pragma unroll
                for (int n = 0; n < 2; ++n) acc[a][b][m][n] = (f32x4){0.f, 0.f, 0.f, 0.f};
    bf16x8 At[4][2], B0[2][2], B1[2][2];
    const char* cA = (const char*)g.A + (size_t)cur.pm * tstep; const char* cB = (const char*)g.Bt + (size_t)cur.pn * tstep;
    S.a_ready(cur);
    if constexpr (SP2) {
        PG8_STAGE(PG8_SB(0, 0), cB, voffB); PG8_STAGE(PG8_SB(0, 1), cB + hstep, voffB); PG8_STAGE(PG8_SA(0, 0), cA, voffA); PG8_STAGE(PG8_SA(0, 1), cA + hstep, voffA);
        if (wr == 1) PG8_BAR;
        PG8_WAIT_V(2); PG8_BAR;
        PG8_STAGE(PG8_SB(1, 0), cB + kstep, voffB); PG8_STAGE(PG8_SA(1, 0), cA + kstep, voffA); PG8_STAGE(PG8_SB(1, 1), cB + hstep + kstep, voffB);
        PG8_WAIT_V(6); PG8_BAR;
    } else {
        PG8_STAGE(PG8_SB(0, 0), cB, voffB); PG8_STAGE(PG8_SA(0, 0), cA, voffA); PG8_STAGE(PG8_SB(0, 1), cB + hstep, voffB); PG8_STAGE(PG8_SA(0, 1), cA + hstep, voffA);
        if (wr == 1) PG8_BAR;
        PG8_WAIT_V(4); PG8_BAR;
        PG8_STAGE(PG8_SB(1, 0), cB + kstep, voffB); PG8_STAGE(PG8_SA(1, 0), cA + kstep, voffA); PG8_STAGE(PG8_SB(1, 1), cB + hstep + kstep, voffB);
        PG8_WAIT_V(6); PG8_BAR;
    }
    for (;;) {
        const bool has_next = S.next(ui + 1, nxt);
        const char* nA = has_next ? (const char*)g.A + (size_t)nxt.pm * tstep : cA; const char* nB = has_next ? (const char*)g.Bt + (size_t)nxt.pn * tstep : cB;
        for (int t = 0; t < nt; t += 2) {
            const bool last = (t == nt - 2);
            const char* a1 = cA + (size_t)(t + 1) * kstep;
            const char* a2 = last ? nA : cA + (size_t)(t + 2) * kstep; const char* b2 = last ? nB : cB + (size_t)(t + 2) * kstep;
            const char* a3 = a2 + kstep; const char* b3 = b2 + kstep;
            if (last && has_next) S.a_ready(nxt);
            if constexpr (SP2) {
            PG8_LDB(B0, 0, 0); PG8_LDB(B1, 0, 1); PG8_SCHED; PG8_LDA(At, 0, 0); PG8_STAGE(PG8_SA(1, 1), a1 + hstep, voffA);
            PG8_WAIT_V(8); PG8_WAIT_L(0); PG8_BAR; PG8_MMA(0, 0, At, B0); PG8_MMA(0, 1, At, B1); PG8_BAR; PG8_SCHED;
            PG8_LDA(At, 0, 1); PG8_STAGE(PG8_SB(0, 0), b2, voffB); PG8_STAGE(PG8_SB(0, 1), b2 + hstep, voffB); PG8_STAGE(PG8_SA(0, 0), a2, voffA);
            PG8_WAIT_V(8); PG8_WAIT_L(0); PG8_BAR; PG8_MMA(1, 0, At, B0); PG8_MMA(1, 1, At, B1); PG8_BAR; PG8_SCHED;
            PG8_LDB(B0, 1, 0); PG8_LDB(B1, 1, 1); PG8_SCHED; PG8_LDA(At, 1, 0); PG8_STAGE(PG8_SA(0, 1), a2 + hstep, voffA);
            PG8_WAIT_V(8); PG8_WAIT_L(0); PG8_BAR; PG8_MMA(0, 0, At, B0); PG8_MMA(0, 1, At, B1); PG8_BAR; PG8_SCHED;
            PG8_LDA(At, 1, 1); PG8_STAGE(PG8_SB(1, 0), b3, voffB); PG8_STAGE(PG8_SB(1, 1), b3 + hstep, voffB); PG8_STAGE(PG8_SA(1, 0), a3, voffA);
            PG8_WAIT_V(8); PG8_WAIT_L(0); PG8_BAR; PG8_MMA(1, 0, At, B0); PG8_MMA(1, 1, At, B1); PG8_BAR; PG8_SCHED;
            } else {
            PG8_LDB(B0, 0, 0); PG8_SCHED; PG8_LDA(At, 0, 0); PG8_STAGE(PG8_SA(1, 1), a1 + hstep, voffA);
            PG8_WAIT_L(8); PG8_BAR; PG8_WAIT_L(0); PG8_MMA(0, 0, At, B0); PG8_BAR; PG8_SCHED;
            PG8_LDB(B1, 0, 1); PG8_STAGE(PG8_SB(0, 0), b2, voffB);
            PG8_BAR; PG8_WAIT_L(0); PG8_MMA(0, 1, At, B1); PG8_BAR;
            PG8_LDA(At, 0, 1); PG8_STAGE(PG8_SA(0, 0), a2, voffA);
            PG8_BAR; PG8_WAIT_L(0); PG8_MMA(1, 0, At, B0); PG8_BAR; PG8_SCHED;
            PG8_STAGE(PG8_SB(0, 1), b2 + hstep, voffB);
            PG8_WAIT_V(6); PG8_BAR; PG8_MMA(1, 1, At, B1); PG8_BAR;
            PG8_LDB(B0, 1, 0); PG8_SCHED; PG8_LDA(At, 1, 0); PG8_STAGE(PG8_SA(0, 1), a2 + hstep, voffA);
            PG8_WAIT_L(8); PG8_BAR; PG8_WAIT_L(0); PG8_MMA(0, 0, At, B0); PG8_BAR; PG8_SCHED;
            PG8_LDB(B1, 1, 1); PG8_STAGE(PG8_SB(1, 0), b3, voffB);
            PG8_BAR; PG8_WAIT_L(0); PG8_MMA(0, 1, At, B1); PG8_BAR;
            PG8_LDA(At, 1, 1); PG8_STAGE(PG8_SA(1, 0), a3, voffA);
            PG8_BAR; PG8_WAIT_L(0); PG8_MMA(1, 0, At, B0); PG8_BAR; PG8_SCHED;
            PG8_STAGE(PG8_SB(1, 1), b3 + hstep, voffB);
            PG8_WAIT_V(6); PG8_BAR; PG8_MMA(1, 1, At, B1); PG8_BAR;
            }
        }
        if constexpr (ALIGN_EPI) { if (wr == 0) PG8_BAR; }
        if constexpr (!Epi::AFTER_DRAIN) { E(acc, cur, wr, wc, fr, fq); S.done(cur); }
        if (!has_next) break;
#pragma unroll
        for (int a = 0; a < 2; ++a)
#pragma unroll
            for (int b = 0; b < 2; ++b)
#pragma unroll
                for (int m = 0; m < 4; ++m)
#pragma unroll
                    for (int n = 0; n < 2; ++n) acc[a][b][m][n] = (f32x4){0.f, 0.f, 0.f, 0.f};
        cur = nxt; cA = nA; cB = nB; ++ui;
        if constexpr (ALIGN_EPI) { if (wr == 1) PG8_BAR; }
    }
    PG8_WAIT_V(0);
    if constexpr (!ALIGN_EPI) { if (wr == 0) PG8_BAR; }
    PG8_BAR;
    if constexpr (Epi::AFTER_DRAIN) { E.fused(acc, cur, wr, wc, fr, fq, lds, wid, lane); S.done(cur); }
#undef PG8_SA
#undef PG8_SB
#undef PG8_STAGE
#undef PG8_LDA
#undef PG8_LDB
#undef PG8_MMA
#undef PG8_WAIT_V
#undef PG8_WAIT_L
#undef PG8_BAR
#undef PG8_SCHED
}
}

struct EpiUp2 {
    static constexpr bool PERM = true, AFTER_DRAIN = false;
    const float* sumsq; bf16_t* U;
    DI void operator()(const pg8::f32x4 (&acc)[2][2][4][2], const pg8::Unit& u, int wr, int wc, int fr, int fq) const {
        const int row0 = u.pm * 256 + wr * 64 + fr, col0 = u.pn * 256 + wc * 32 + 8 * fq;
#pragma unroll
        for (int ai = 0; ai < 2; ++ai)
#pragma unroll
            for (int m = 0; m < 4; ++m) {
                const int row = row0 + ai * 128 + m * 16;
                bf16_t* rp = U + (size_t)row * 4096 + col0;
#pragma unroll
                for (int bj = 0; bj < 2; ++bj) {
                    float v[8];
#pragma unroll
                    for (int n = 0; n < 2; ++n)
#pragma unroll
                        for (int e = 0; e < 4; ++e) { const float t = fmaxf(acc[ai][bj][m][n][e], 0.f); v[4 * n + e] = t * t; }
                    u32x4 w; w.x = pk_bf16(v[0], v[1]); w.y = pk_bf16(v[2], v[3]); w.z = pk_bf16(v[4], v[5]); w.w = pk_bf16(v[6], v[7]);
                    *(u32x4*)(rp + bj * 128) = w;
                }
            }
    }
};

struct EpiRes2 {
    static constexpr bool PERM = true, AFTER_DRAIN = false;
    const float* resid; float* hout; bf16_t* hb; float* sumsq_next; const float* sumsq_in;
    DI void operator()(const pg8::f32x4 (&acc)[2][2][4][2], const pg8::Unit& u, int wr, int wc, int fr, int fq) const {
        const int row0 = u.pm * 256 + wr * 64 + fr, col0 = u.pn * 256 + wc * 32 + 8 * fq;
#pragma unroll
        for (int ai = 0; ai < 2; ++ai)
#pragma unroll
            for (int m = 0; m < 4; ++m) {
                const int row = row0 + ai * 128 + m * 16; float ss = 0.f;
                const float r2 = sumsq_in ? 1.0f / (sumsq_in[row] * (1.0f / 1024.0f) + EPS) : 1.0f;
#pragma unroll
                for (int bj = 0; bj < 2; ++bj) {
                    const size_t off = (size_t)row * 1024 + col0 + bj * 128;
                    f32x4 r0 = *(const f32x4*)(resid + off), r1 = *(const f32x4*)(resid + off + 4);
#pragma unroll
                    for (int e = 0; e < 4; ++e) { r0[e] += acc[ai][bj][m][0][e] * r2; r1[e] += acc[ai][bj][m][1][e] * r2; ss += r0[e] * r0[e] + r1[e] * r1[e]; }
                    *(f32x4*)(hout + off) = r0; *(f32x4*)(hout + off + 4) = r1;
                    u32x4 w; w.x = pk_bf16(r0[0], r0[1]); w.y = pk_bf16(r0[2], r0[3]); w.z = pk_bf16(r1[0], r1[1]); w.w = pk_bf16(r1[2], r1[3]);
                    if (hb) *(u32x4*)(hb + off) = w;
                }
                ss += __shfl_xor(ss, 16); ss += __shfl_xor(ss, 32);
                if (fq == 0) __hip_atomic_fetch_add(sumsq_next + row, ss, __ATOMIC_RELAXED, __HIP_MEMORY_SCOPE_AGENT);
                asm volatile("" ::: "memory");
            }
    }
};

DI void rope8(float (&v)[8], const float* __restrict__ rope, int s, int fq) {
    const f32x4 c0 = *(const f32x4*)(rope + s * 16), c1 = *(const f32x4*)(rope + s * 16 + 4), s0 = *(const f32x4*)(rope + s * 16 + 8), s1 = *(const f32x4*)(rope + s * 16 + 12);
    const float cs[8] = {c0[0], c0[1], c0[2], c0[3], c1[0], c1[1], c1[2], c1[3]}, sn[8] = {s0[0], s0[1], s0[2], s0[3], s1[0], s1[1], s1[2], s1[3]};
#pragma unroll
    for (int e = 0; e < 8; ++e) {
        const float other = __shfl_xor(v[e], 16);
        const float a = v[e] * cs[e], bq = other * sn[e];
        v[e] = (fq == 0) ? (a - bq) : ((fq == 1) ? (a + bq) : v[e]);
    }
}

struct EpiProj0b {
    static constexpr bool PERM = true, AFTER_DRAIN = false;
    const float* sumsq; bf16_t* P; bf16_t* vta; bf16_t* vtf; float* logf; const float* bfg; const float* rope;
    DI void operator()(const pg8::f32x4 (&acc)[2][2][4][2], const pg8::Unit& u, int wr, int wc, int fr, int fq) const {
        const int row0 = u.pm * 256 + wr * 64 + fr;
#pragma unroll
        for (int bj = 0; bj < 2; ++bj) {
            const int cb = u.pn * 256 + bj * 128;
            if (cb > 3072) continue;
            if (cb == 3072 && wc != 0) continue;
            const int col0 = cb + wc * 32 + 8 * fq;
            const int region = cb >> 9;
#pragma unroll
            for (int ai = 0; ai < 2; ++ai)
#pragma unroll
                for (int m = 0; m < 4; ++m) {
                    const int row = row0 + ai * 128 + m * 16;
                    const float rstd = rsqrtf(sumsq[row] * (1.0f / 1024.0f) + EPS);
                    const int s = row & (SEQ - 1), b = row >> 13;
                    float v[8];
#pragma unroll
                    for (int n = 0; n < 2; ++n)
#pragma unroll
                        for (int e = 0; e < 4; ++e) v[4 * n + e] = acc[ai][bj][m][n][e] * rstd;
                    if (cb == 3072) {
                        if (fq == 0) {
                            f32x4 o0, o1;
#pragma unroll
                            for (int e = 0; e < 4; ++e) {
                                const float x0 = v[e] + bfg[e], x1 = v[4 + e] + bfg[4 + e];
                                o0[e] = fminf(x0, 0.f) - __logf(1.0f + __expf(-fabsf(x0))); o1[e] = fminf(x1, 0.f) - __logf(1.0f + __expf(-fabsf(x1)));
                            }
                            *(f32x4*)(logf + (size_t)row * 8) = o0; *(f32x4*)(logf + (size_t)row * 8 + 4) = o1;
                        }
                    } else if (region == 2 || region == 5) {
                        const int c = col0 - region * 512;
                        bf16_t* vt = (region == 2 ? vta : vtf) + ((size_t)(b * 512 + c) * SEQ + s);
#pragma unroll
                        for (int e = 0; e < 8; ++e) vt[(size_t)e * SEQ] = to_bf16(v[e]);
                    } else {
                        if (region < 2 && (wc & 1) == 0) rope8(v, rope, s, fq);
                        const float qs = (region == 0 || region == 3) ? QSCALE : 1.0f;
                        u32x4 w; w.x = pk_bf16(v[0] * qs, v[1] * qs); w.y = pk_bf16(v[2] * qs, v[3] * qs); w.z = pk_bf16(v[4] * qs, v[5] * qs); w.w = pk_bf16(v[6] * qs, v[7] * qs);
                        *(u32x4*)(P + (size_t)row * P0_PITCH + col0) = w;
                    }
                    asm volatile("" ::: "memory");
                }
        }
    }
};

struct EpiProj1b {
    static constexpr bool PERM = true, AFTER_DRAIN = false;
    const float* sumsq; bf16_t* P; bf16_t* vt1; float* ikraw; float* iw; const float* rope;
    DI void operator()(const pg8::f32x4 (&acc)[2][2][4][2], const pg8::Unit& u, int wr, int wc, int fr, int fq) const {
        const int row0 = u.pm * 256 + wr * 64 + fr;
#pragma unroll
        for (int bj = 0; bj < 2; ++bj) {
            const int cb = u.pn * 256 + bj * 128;
            if (cb > 3584) continue;
            if (cb == 3584 && wc == 3) continue;
            const int col0 = cb + wc * 32 + 8 * fq;
#pragma unroll
            for (int ai = 0; ai < 2; ++ai)
#pragma unroll
                for (int m = 0; m < 4; ++m) {
                    const int row = row0 + ai * 128 + m * 16;
                    const float rstd = rsqrtf(sumsq[row] * (1.0f / 1024.0f) + EPS);
                    const int s = row & (SEQ - 1), b = row >> 13;
                    float v[8];
#pragma unroll
                    for (int n = 0; n < 2; ++n)
#pragma unroll
                        for (int e = 0; e < 4; ++e) v[4 * n + e] = acc[ai][bj][m][n][e] * rstd;
                    if (cb == 3584) {
                        if (wc < 2) {
                            float* d = ikraw + (size_t)row * 64 + wc * 32 + 8 * fq;
                            *(f32x4*)d = (f32x4){v[0], v[1], v[2], v[3]}; *(f32x4*)(d + 4) = (f32x4){v[4], v[5], v[6], v[7]};
                        } else if (fq == 0) {
                            const float sc = 0.044194173824159216f;
                            *(f32x4*)(iw + (size_t)row * 8) = (f32x4){v[0] * sc, v[1] * sc, v[2] * sc, v[3] * sc}; *(f32x4*)(iw + (size_t)row * 8 + 4) = (f32x4){v[4] * sc, v[5] * sc, v[6] * sc, v[7] * sc};
                        }
                    } else if (cb >= 2048 && cb < 3072) {
                        const int c = col0 - 2048;
                        bf16_t* vt = vt1 + ((size_t)(b * 1024 + c) * SEQ + s);
#pragma unroll
                        for (int e = 0; e < 8; ++e) vt[(size_t)e * SEQ] = to_bf16(v[e]);
                    } else {
                        if ((wc & 1) == 0) rope8(v, rope, s, fq);
                        const float qs = (cb < 1024) ? QSCALE : 1.0f;
                        u32x4 w; w.x = pk_bf16(v[0] * qs, v[1] * qs); w.y = pk_bf16(v[2] * qs, v[3] * qs); w.z = pk_bf16(v[4] * qs, v[5] * qs); w.w = pk_bf16(v[6] * qs, v[7] * qs);
                        *(u32x4*)(P + (size_t)row * P1_PITCH + col0) = w;
                    }
                    asm volatile("" ::: "memory");
                }
        }
    }
};

DI void phase_iknorm(const Params& p) {
    const int tid = threadIdx.x, lane = tid & 63, wid = tid >> 6;
    const float* ikraw = (const float*)(p.ws + WS_BITMASK);
    bf16_t* ikb = (bf16_t*)(p.ws + WS_IKB);
    const float* rope = (const float*)(p.ws + WS_ROPE);
    const float g = p.in[11][lane], bt = p.in[12][lane];
    for (int row = blockIdx.x * 8 + wid; row < T_TOK; row += gridDim.x * 8) {
        const float x = ikraw[(size_t)row * 64 + lane];
        const float mean = wave_sum(x) * (1.0f / 64.0f);
        const float d = x - mean;
        const float var = wave_sum(d * d) * (1.0f / 64.0f);
        float y = d * rsqrtf(var + EPS) * g + bt;
        const int s = row & (SEQ - 1);
        const float other = __shfl_xor(y, 8);
        const float cs = rope[s * 16 + (lane & 7)], sn = rope[s * 16 + 8 + (lane & 7)];
        if (lane < 8) y = y * cs - other * sn; else if (lane < 16) y = y * cs + other * sn;
        ikb[(size_t)row * 64 + lane] = to_bf16(y);
    }
}

DI void phase_scan(const Params& p, unsigned char* lds) {
    {
        const bf16_t* P = (const bf16_t*)(p.ws + WS_PBUF);
        unsigned* bnd = (unsigned*)(p.ws + WS_BND);
        for (int u = blockIdx.x; u < 256; u += gridDim.x) {
            const int bh = u >> 3, b = bh >> 3, h = bh & 7, chunk = u & 7;
            float qm = 0.f, km = 0.f;
#pragma unroll
            for (int j = 0; j < 2; ++j) {
                const int s = chunk * 1024 + j * 512 + (int)threadIdx.x;
                const bf16_t* row = P + (size_t)(b * SEQ + s) * P0_PITCH + h * 64;
                float qs = 0.f, ks = 0.f;
#pragma unroll
                for (int c = 0; c < 8; ++c) {
                    const u32x4 qv = *(const u32x4*)(row + 1536 + c * 8), kv = *(const u32x4*)(row + 2048 + c * 8);
#pragma unroll
                    for (int e = 0; e < 4; ++e) {
                        const float q0 = __uint_as_float(qv[e] << 16), q1 = __uint_as_float(qv[e] & 0xffff0000u);
                        const float k0 = __uint_as_float(kv[e] << 16), k1 = __uint_as_float(kv[e] & 0xffff0000u);
                        qs += q0 * q0 + q1 * q1; ks += k0 * k0 + k1 * k1;
                    }
                }
                qm = fmaxf(qm, qs); km = fmaxf(km, ks);
            }
#pragma unroll
            for (int d = 32; d >= 1; d >>= 1) { qm = fmaxf(qm, __shfl_xor(qm, d)); km = fmaxf(km, __shfl_xor(km, d)); }
            if ((threadIdx.x & 63) == 0) { atomicMax(bnd + bh * 2, __float_as_uint(qm)); atomicMax(bnd + bh * 2 + 1, __float_as_uint(km)); }
        }
    }
    const float* logf = (const float*)(p.ws + WS_LOGF);
    float* c2 = (float*)(p.ws + WS_C2);
    float* wsum = (float*)lds;
    const int tid = threadIdx.x, lane = tid & 63, wid = tid >> 6;
    for (int u = blockIdx.x; u < 32; u += gridDim.x) {
        const int b = u >> 3, h = u & 7;
        float v[16]; float tot = 0.f;
#pragma unroll
        for (int j = 0; j < 16; ++j) { v[j] = logf[((size_t)b * SEQ + tid * 16 + j) * 8 + h]; tot += v[j]; v[j] = tot; }
        float inc = tot;
#pragma unroll
        for (int d = 1; d < 64; d <<= 1) { const float o = __shfl_up(inc, d); if (lane >= d) inc += o; }
        if (lane == 63) wsum[wid] = inc;
        __syncthreads();
        float base = inc - tot;
        for (int w = 0; w < wid; ++w) base += wsum[w];
#pragma unroll
        for (int j = 0; j < 16; ++j) c2[((size_t)(b * 8 + h)) * SEQ + tid * 16 + j] = (base + v[j]) * LOG2E;
        __syncthreads();
    }
}

template <int MODE, int DRY = 0>
DI void attn_phase(const Params& p, unsigned char* lds) {
    constexpr int DVB = (MODE == 0) ? 4 : 2;
    constexpr int QU = (MODE == 0) ? 128 : 256;
    constexpr int NH = (MODE == 0) ? 4 : (MODE == 1 ? 8 : 16);
    constexpr int NQB = SEQ / QU, NBH = 4 * NH, NUNITS = NQB * NBH;
    constexpr int NJ = (MODE == 0) ? 4 : 2, NKJ = NJ / 2;
    constexpr int VT_OFF = (MODE == 0) ? 18432 : 9216;
    constexpr int CK_OFF = 17920;
    constexpr int STG = (MODE == 0) ? 35840 : 18432;
    constexpr int XCH_OFF = 3 * 35840;
    const int tid = threadIdx.x, lane = tid & 63, wid = tid >> 6, r32 = lane & 31, hh = lane >> 5;
    const int lrow = tid >> 3, lkc = tid & 7;
    const int G = gridDim.x;
    unsigned char* ws = p.ws;
    const bf16_t* P = (const bf16_t*)(ws + WS_PBUF);
    const bf16_t* VT = (const bf16_t*)(ws + WS_VT) + (MODE == 1 ? (size_t)4 * 512 * SEQ : 0);
    bf16_t* mixed = (bf16_t*)(ws + WS_MIXED);
    const float* c2 = (const float*)(ws + WS_C2);
    const u64* bitmask = (const u64*)(ws + WS_BITMASK);
    constexpr int PITCH = (MODE == 2) ? P1_PITCH : P0_PITCH;
    float lam = 0.f;
    if (MODE == 0) {
        float d1 = 0.f, d2 = 0.f;
        for (int i = 0; i < 64; ++i) { d1 += p.in[4][i] * p.in[5][i]; d2 += p.in[6][i] * p.in[7][i]; }
        lam = expf(d1) - expf(d2) + 0.2f;
    }
    for (int it = 0; it * G < NUNITS; ++it) {
        int qb, bh;
        if (MODE == 1 && G == 256) {
            const int p_ = (int)blockIdx.x, hbase = p_ & 7, bsel = (p_ >> 3) & 3, qgrp = p_ >> 5;
            qb = 8 * (3 - it) + qgrp; bh = bsel * 8 + ((hbase + 3 * it) & 7);
        } else {
            const int pos = (it & 1) ? (G - 1 - (int)blockIdx.x) : (int)blockIdx.x;
            const int u = it * G + pos;
            if (u >= NUNITS) continue;
            qb = NQB - 1 - u / NBH; bh = u % NBH;
        }
        const int b = bh / NH, h = bh % NH;
        const int q0 = qb * QU;
        const int cmap = (MODE == 0) ? (wid >> 2) : 0;
        const int qw0 = q0 + 32 * ((MODE == 0) ? (wid & 3) : wid);
        const int nt = (q0 + QU) >> 6;
        const int myq = qw0 + r32;
        int j0 = 0;
        if (MODE == 1) {
            const unsigned* bnd = (const unsigned*)(ws + WS_BND) + (b * 8 + h) * 2;
            const float Bnd = sqrtf(__uint_as_float(bnd[0]) * __uint_as_float(bnd[1])) * 1.02f + 0.5f;
            const float thr = -(2.0f * Bnd + 30.0f);
            const float* cc = c2 + (size_t)(b * 8 + h) * SEQ;
            const float cq0 = cc[q0];
            int lo = 0, hi = q0 >> 6;
            while (lo < hi) { const int mid = (lo + hi) >> 1; if (cq0 - cc[64 * mid + 63] >= thr) hi = mid; else lo = mid + 1; }
            j0 = lo;
        }
        const int ntl = nt - j0;
        const bf16_t* src[NJ]; size_t step[NJ];
        if (MODE == 0) {
            src[0] = P + (size_t)(b * SEQ + lrow) * PITCH + 512 + (h * 2) * 64 + lkc * 8; step[0] = (size_t)64 * PITCH;
            src[1] = src[0] + 64; step[1] = step[0];
            src[2] = VT + (size_t)(b * 512 + h * 128 + lrow) * SEQ + lkc * 8; step[2] = 64;
            src[3] = src[2] + (size_t)64 * SEQ; step[3] = 64;
        } else if (MODE == 1) {
            src[0] = P + (size_t)(b * SEQ + lrow) * PITCH + 2048 + h * 64 + lkc * 8; step[0] = (size_t)64 * PITCH;
            src[1] = VT + (size_t)(b * 512 + h * 64 + lrow) * SEQ + lkc * 8; step[1] = 64;
        } else {
            src[0] = P + (size_t)(b * SEQ + lrow) * PITCH + 1024 + h * 64 + lkc * 8; step[0] = (size_t)64 * PITCH;
            src[1] = VT + (size_t)(b * 1024 + h * 64 + lrow) * SEQ + lkc * 8; step[1] = 64;
        }
        const int qcol = (MODE == 0) ? (h * 2 + cmap) * 64 : (MODE == 1 ? 1536 + h * 64 : h * 64);
        bf16x8 qf[4];
#pragma unroll
        for (int ks = 0; ks < 4; ++ks) qf[ks] = *(const bf16x8*)(P + (size_t)(b * SEQ + myq) * PITCH + qcol + 16 * ks + 8 * hh);
        const float* ckp = nullptr;
        if (MODE == 1) ckp = c2 + (size_t)(b * 8 + h) * SEQ;
        const u64* mrow = nullptr; u64 wcur = 0, wnext = 0, wnext2 = 0;
        if (MODE == 2) { mrow = bitmask + (size_t)(b * SEQ + myq) * 128; wcur = mrow[0]; }
        f32x16 o[DVB];
#pragma unroll
        for (int db = 0; db < DVB; ++db)
#pragma unroll
            for (int i = 0; i < 16; ++i) o[db][i] = 0.f;
        float m = -1e30f, l = 0.f;
        constexpr bool DEEP = (MODE != 0);
        u32x4 rgE[NJ], rgO[NJ]; float ckrE = 0.f, ckrO = 0.f;
        auto gload = [&](u32x4 (&rg)[NJ], float& ckr, int t) {
#pragma unroll
            for (int j = 0; j < NJ; ++j) rg[j] = *(const u32x4*)(src[j] + (size_t)t * step[j]);
            if (MODE == 1 && tid < 64) ckr = ckp[t * 64 + tid];
        };
        auto lstore = [&](const u32x4 (&rg)[NJ], const float ckr, int stg) {
            unsigned char* sb = lds + stg * STG;
#pragma unroll
            for (int j = 0; j < NJ; ++j) {
                if (j < NKJ) *(u32x4*)(sb + j * 9216 + lrow * 144 + lkc * 16) = rg[j];
                else { unsigned char* d = sb + VT_OFF + (lrow + 64 * (j - NKJ)) * 136 + lkc * 16; u32x2 a, c; a.x = rg[j].x; a.y = rg[j].y; c.x = rg[j].z; c.y = rg[j].w; *(u32x2*)d = a; *(u32x2*)(d + 8) = c; }
            }
            if (MODE == 1 && tid < 64) *(float*)(sb + CK_OFF + tid * 4) = ckr;
        };
        const unsigned koff = cmap * 9216 + r32 * 144 + hh * 16;
        const unsigned voff = VT_OFF + r32 * 136 + hh * 8;
        auto qk = [&](f32x16 (&s)[2], float& mi, int stg) {
            const unsigned char* kb_ = lds + stg * STG + koff;
            const unsigned mb = pk_bf16((m > -1e29f) ? -m : 0.f, 0.f) & 0xffffu;
            mi = -__uint_as_float(mb << 16);
            u32x4 qxw; qxw.x = hh ? 0u : mb; qxw.y = 0u; qxw.z = 0u; qxw.w = 0u;
            u32x4 kxw; kxw.x = hh ? 0u : 0x3f80u; kxw.y = 0u; kxw.z = 0u; kxw.w = 0u;
            const bf16x8 qx = __builtin_bit_cast(bf16x8, qxw), kx = __builtin_bit_cast(bf16x8, kxw);
            f32x16 zero;
#pragma unroll
            for (int i = 0; i < 16; ++i) zero[i] = 0.f;
#pragma unroll
            for (int blk = 0; blk < 2; ++blk) {
                s[blk] = MFMA32(kx, qx, zero);
#pragma unroll
                for (int ks = 0; ks < 4; ++ks) {
                    const bf16x8 kf = *(const bf16x8*)(kb_ + blk * 4608 + ks * 32);
                    s[blk] = MFMA32(kf, qf[ks], s[blk]);
                }
            }
        };
        auto softmax_pv = [&](f32x16 (&s)[2], const float mi, int kt, int stg) {
            const int k0 = kt * 64;
            const unsigned char* sb = lds + stg * STG;
            if (DRY != 1) {
            if (MODE == 1) {
#pragma unroll
                for (int blk = 0; blk < 2; ++blk)
#pragma unroll
                    for (int g = 0; g < 4; ++g) {
                        const f32x4 c4 = *(const f32x4*)(sb + CK_OFF + (32 * blk + 8 * g + 4 * hh) * 4);
#pragma unroll
                        for (int e = 0; e < 4; ++e) s[blk][4 * g + e] -= c4[e];
                    }
            }
            if (MODE == 2) {
                const u64 wsh = wcur >> (4 * hh);
                const int wlo = (int)(unsigned)wsh, whi = (int)(unsigned)(wsh >> 32);
#pragma unroll
                for (int i = 0; i < 16; ++i) {
                    const int bit = (i & 3) + 8 * (i >> 2);
                    const unsigned m0 = (unsigned)__builtin_amdgcn_sbfe(wlo, bit, 1), m1 = (unsigned)__builtin_amdgcn_sbfe(whi, bit, 1);
                    s[0][i] = __uint_as_float((__float_as_uint(s[0][i]) & m0) | (0xff800000u & ~m0));
                    s[1][i] = __uint_as_float((__float_as_uint(s[1][i]) & m1) | (0xff800000u & ~m1));
                }
            } else if (k0 + 63 > qw0) {
#pragma unroll
                for (int blk = 0; blk < 2; ++blk)
#pragma unroll
                    for (int i = 0; i < 16; ++i) { const int key = k0 + 32 * blk + crow(i, hh); if (key > myq) s[blk][i] = -INFINITY; }
            }
            float mx = s[0][0];
#pragma unroll
            for (int i = 1; i < 16; ++i) mx = fmaxf(mx, s[0][i]);
#pragma unroll
            for (int i = 0; i < 16; ++i) mx = fmaxf(mx, s[1][i]);
            mx = xhalf_max(mx);
            const float mabs = mi + mx;
            const bool up = mabs > m + 8.0f;
            const float mn = up ? __uint_as_float(pk_bf16(mabs, 0.f) << 16) : m;
            const float shift = mn - mi;
            if (__ballot(shift != 0.f) != 0) {
                if (__ballot(up) != 0) {
                    const float alpha = __builtin_amdgcn_exp2f(m - mn);
                    l *= alpha;
#pragma unroll
                    for (int db = 0; db < DVB; ++db)
#pragma unroll
                        for (int i = 0; i < 16; ++i) o[db][i] *= alpha;
                    m = mn;
                }
#pragma unroll
                for (int blk = 0; blk < 2; ++blk)
#pragma unroll
                    for (int i = 0; i < 16; ++i) s[blk][i] -= shift;
            }
            float ls = 0.f;
#pragma unroll
            for (int blk = 0; blk < 2; ++blk)
#pragma unroll
                for (int i = 0; i < 16; ++i) { const float e = __builtin_amdgcn_exp2f(s[blk][i]); s[blk][i] = e; ls += e; }
            l += ls;
            }
#pragma unroll
            for (int blk = 0; blk < 2; ++blk)
#pragma unroll
                for (int sp = 0; sp < 2; ++sp) {
                    u32x4 pw;
                    pw.x = pk_bf16(s[blk][8 * sp + 0], s[blk][8 * sp + 1]); pw.y = pk_bf16(s[blk][8 * sp + 2], s[blk][8 * sp + 3]);
                    pw.z = pk_bf16(s[blk][8 * sp + 4], s[blk][8 * sp + 5]); pw.w = pk_bf16(s[blk][8 * sp + 6], s[blk][8 * sp + 7]);
                    const bf16x8 pf = __builtin_bit_cast(bf16x8, pw);
#pragma unroll
                    for (int db = 0; db < DVB; ++db) {
                        const unsigned char* va = sb + voff + db * 32 * 136 + (32 * blk + 16 * sp) * 2;
                        const u32x2 lo = *(const u32x2*)va, hi = *(const u32x2*)(va + 16);
                        u32x4 vw; vw.x = lo.x; vw.y = lo.y; vw.z = hi.x; vw.w = hi.y;
                        o[db] = MFMA32(__builtin_bit_cast(bf16x8, vw), pf, o[db]);
                    }
                }
        };
        auto stepf = [&](f32x16 (&s_cur)[2], const float mi_cur, f32x16 (&s_nxt)[2], float& mi_nxt, u32x4 (&rg_ld)[NJ], float& ck_ld, const u32x4 (&rg_st)[NJ], const float ck_st, int kk) {
            const int kt = j0 + kk;
            if (DEEP) { if (kk + 3 < ntl) gload(rg_ld, ck_ld, kt + 3); } else { if (kk + 2 < ntl) gload(rg_ld, ck_ld, kt + 2); }
            if (MODE == 2 && kk + 2 < ntl) wnext2 = mrow[kt + 2];
            if (kk + 1 < ntl && (kt + 1) * 64 <= qw0 + 31) qk(s_nxt, mi_nxt, (kk + 1) % 3);
            if (kt * 64 <= qw0 + 31) softmax_pv(s_cur, mi_cur, kt, kk % 3);
            if (MODE == 2) { wcur = wnext; wnext = wnext2; }
            if (kk + 2 < ntl) lstore(rg_st, ck_st, (kk + 2) % 3);
            __syncthreads();
        };
        gload(rgE, ckrE, j0); lstore(rgE, ckrE, 0);
        if (ntl > 1) { gload(rgE, ckrE, j0 + 1); lstore(rgE, ckrE, 1); }
        if (DEEP && ntl > 2) gload(rgO, ckrO, j0 + 2);
        if (MODE == 2 && ntl > 1) wnext = mrow[j0 + 1];
        __syncthreads();
        f32x16 sA[2], sB[2]; float miA = 0.f, miB = 0.f;
        if (j0 * 64 <= qw0 + 31) qk(sA, miA, 0);
        for (int kk = 0; kk < ntl; kk += 2) {
            if (DEEP) {
                stepf(sA, miA, sB, miB, rgE, ckrE, rgO, ckrO, kk);
                if (kk + 1 < ntl) stepf(sB, miB, sA, miA, rgO, ckrO, rgE, ckrE, kk + 1);
            } else {
                stepf(sA, miA, sB, miB, rgE, ckrE, rgE, ckrE, kk);
                if (kk + 1 < ntl) stepf(sB, miB, sA, miA, rgE, ckrE, rgE, ckrE, kk + 1);
            }
        }
        l = xhalf_sum(l);
        const float inv = 1.0f / l;
        const int tok = b * SEQ + myq;
        if (DRY != 0 && o[0][0] != 12345.678f) continue;
        if (MODE == 0) {
            float* xch = (float*)(lds + XCH_OFF);
            const int qs = wid & 3;
#pragma unroll
            for (int db = 0; db < DVB; ++db) {
                if (cmap == 1) {
#pragma unroll
                    for (int i = 0; i < 16; ++i) xch[(qs * 16 + i) * 64 + lane] = o[db][i] * inv;
                }
                __syncthreads();
                if (cmap == 0) {
#pragma unroll
                    for (int i = 0; i < 16; ++i) o[db][i] = o[db][i] * inv - lam * xch[(qs * 16 + i) * 64 + lane];
                }
                __syncthreads();
            }
            if (cmap == 0) {
                float ss = 0.f;
#pragma unroll
                for (int db = 0; db < DVB; ++db)
#pragma unroll
                    for (int i = 0; i < 16; ++i) ss += o[db][i] * o[db][i];
                ss = xhalf_sum(ss);
                const float rn = rsqrtf(ss * (1.0f / 128.0f) + EPS) * 0.8f;
                const float* subg = p.in[8];
#pragma unroll
                for (int db = 0; db < DVB; ++db)
#pragma unroll
                    for (int g = 0; g < 4; ++g) {
                        const int d0 = 32 * db + 8 * g + 4 * hh;
                        const f32x4 gg = *(const f32x4*)(subg + d0);
                        store4_bf16(mixed + (size_t)tok * 1024 + h * 128 + d0, o[db][4 * g] * rn * gg[0], o[db][4 * g + 1] * rn * gg[1], o[db][4 * g + 2] * rn * gg[2], o[db][4 * g + 3] * rn * gg[3]);
                    }
            }
        } else {
            const int cbase = (MODE == 1) ? 512 + h * 64 : h * 64;
#pragma unroll
            for (int db = 0; db < DVB; ++db)
#pragma unroll
                for (int g = 0; g < 4; ++g)
                    store4_bf16(mixed + (size_t)tok * 1024 + cbase + 32 * db + 8 * g + 4 * hh, o[db][4 * g] * inv, o[db][4 * g + 1] * inv, o[db][4 * g + 2] * inv, o[db][4 * g + 3] * inv);
        }
    }
}

DI unsigned sortable(float x) { if (x == 0.f) x = 0.f; const unsigned u = __float_as_uint(x); return (u & 0x80000000u) ? ~u : (u | 0x80000000u); }

DI void hist_select(const unsigned* hrow, int need, int lane, int& bsel, int& above, bool& hit) {
    const u32x4 w0 = *(const u32x4*)(hrow + 8 * lane), w1 = *(const u32x4*)(hrow + 8 * lane + 4);
    unsigned wv[8] = {w0.x, w0.y, w0.z, w0.w, w1.x, w1.y, w1.z, w1.w};
    int cnt[16]; int tot = 0;
#pragma unroll
    for (int j = 0; j < 8; ++j) { cnt[2 * j] = (int)(wv[j] & 0xffffu); cnt[2 * j + 1] = (int)(wv[j] >> 16); tot += cnt[2 * j] + cnt[2 * j + 1]; }
    int inc = tot;
#pragma unroll
    for (int d = 1; d < 64; d <<= 1) { const int o = __shfl_down(inc, d); if (lane + d < 64) inc += o; }
    const int exc = inc - tot;
    const bool pred = (inc >= need) && (exc < need);
    const u64 bal = __ballot(pred);
    int mybin = 0, myabove = exc; bool found = false; int run = exc;
#pragma unroll
    for (int j = 15; j >= 0; --j) { if (!found && run + cnt[j] >= need) { found = true; mybin = 16 * lane + j; myabove = run; } run += cnt[j]; }
    hit = (bal != 0);
    if (bal == 0) {
        const int total = __shfl(inc, 0), c0 = __shfl(cnt[0], 0);
        bsel = 0; above = total - c0;
    } else {
        const int L = __ffsll((long long)bal) - 1;
        bsel = __shfl(mybin, L); above = __shfl(myabove, L);
    }
}

template <int N> struct IC { static constexpr int value = N; };

DI void phase_index(const Params& p, unsigned char* lds) {
    constexpr int NUNITS = 4 * 256;
    constexpr int TILE_OFF = 65536, STAGE_B = 36864, INFO_OFF = 65536 + 2 * 36864;
    const int tid = threadIdx.x, lane = tid & 63, wid = tid >> 6, r32 = lane & 31, hh = lane >> 5;
    const int lrow = tid >> 3, lkc = tid & 7;
    const int G = gridDim.x;
    unsigned char* ws = p.ws;
    const bf16_t* P = (const bf16_t*)(ws + WS_PBUF);
    const bf16_t* ikb = (const bf16_t*)(ws + WS_IKB);
    const float* iw = (const float*)(ws + WS_IW);
    u64* bitmask = (u64*)(ws + WS_BITMASK);
    unsigned* hist = (unsigned*)lds;
    int* info = (int*)(lds + INFO_OFF);
    for (int it = 0; it * G < NUNITS; ++it) {
        const int pos = (it & 1) ? (G - 1 - (int)blockIdx.x) : (int)blockIdx.x;
        const int u = it * G + pos;
        if (u >= NUNITS) continue;
        const int qblk = 255 - (u >> 2), b = u & 3;
        const int t0 = qblk * 32;
        const int nt = (t0 >> 6) + 1;
        const int nst = (nt + 3) >> 2;
        bf16x8 qf[4];
        {
            const bf16_t* qp = P + (size_t)(b * SEQ + t0 + 4 * wid + (r32 >> 3)) * P1_PITCH + 3072 + (r32 & 7) * 64 + 8 * hh;
#pragma unroll
            for (int ks = 0; ks < 4; ++ks) qf[ks] = *(const bf16x8*)(qp + 16 * ks);
        }
        f32x4 wq[4];
#pragma unroll
        for (int q = 0; q < 4; ++q) wq[q] = *(const f32x4*)(iw + (size_t)(b * SEQ + t0 + 4 * wid + q) * 8 + 4 * hh);
        const bf16_t* srcp = ikb + (size_t)(b * SEQ + lrow) * 64 + lkc * 8;
        const unsigned st_off = TILE_OFF + lrow * 144 + lkc * 16;
        const unsigned rd_off = TILE_OFF + r32 * 144 + hh * 16;
        int b1v[2] = {0, 0}, tauv[2] = {0, 0};
        int rq[4] = {0, 0, 0, 0}, cntq[4] = {0, 0, 0, 0};
        const unsigned hbase0 = (unsigned)(4 * wid + 2 * hh) * 2048u;
        const int tq0 = t0 + 4 * wid + 2 * hh;
        u64 Gm[4], Em[4];
        int cntA[2] = {0, 0}; int hiv[2] = {0, 0}, sbv[2] = {8, 8}, kshv[2] = {12, 12};
        auto mma = [&](f32x16& s, unsigned off) {
#pragma unroll
            for (int i = 0; i < 16; ++i) s[i] = 0.f;
#pragma unroll
            for (int ks = 0; ks < 4; ++ks) { const bf16x8 kf = *(const bf16x8*)(lds + off + ks * 32); s = MFMA32(qf[ks], kf, s); }
        };
        auto proc = [&](auto PASSC, auto DIAGC, const f32x16& s, int k0, int kb) {
            constexpr int PASS = decltype(PASSC)::value; constexpr bool DIAG = decltype(DIAGC)::value != 0;
            f32x4 tot;
#pragma unroll
            for (int q = 0; q < 4; ++q) {
                float pr = 0.f;
#pragma unroll
                for (int e = 0; e < 4; ++e) pr += wq[q][e] * fmaxf(s[4 * q + e], 0.f);
                tot[q] = xhalf_sum(pr);
            }
            const int key = k0 + 32 * kb + r32;
#pragma unroll
            for (int qq = 0; qq < 2; ++qq) {
                const float t_lo = tot[qq], t_hi = tot[2 + qq];
                const float sc = ((lane & 32) ? t_hi : t_lo) + 0.0f;
                const unsigned ub = __float_as_uint(sc);
                const unsigned uk = ub ^ ((unsigned)((int)ub >> 31) | 0x80000000u);
                const bool valid = DIAG ? (key <= tq0 + qq) : true;
                if (PASS == 0) {
                    if (valid) { const unsigned a = (uk >> 21) & 0x7feu; atomicAdd((unsigned*)(lds + hbase0 + qq * 2048 + (a & ~3u)), 1u << ((a & 2u) << 3)); }
                } else if (PASS == 1) {
                    if (valid && (int)(uk >> 22) == b1v[qq]) { const unsigned a = (uk >> 11) & 0x7feu; atomicAdd((unsigned*)(lds + hbase0 + qq * 2048 + (a & ~3u)), 1u << ((a & 2u) << 3)); }
                } else if (PASS == 3) {
                    if (valid) {
                        const int k10 = (int)(uk >> 22), d = k10 - b1v[qq];
                        if (k10 > hiv[qq]) cntA[qq] += 1;
                        else if (d >= 0) {
                            const unsigned bin = ((unsigned)d << sbv[qq]) | ((uk >> (22 - sbv[qq])) & ((1u << sbv[qq]) - 1u));
                            const unsigned a = bin << 1;
                            atomicAdd((unsigned*)(lds + hbase0 + qq * 2048 + (a & ~3u)), 1u << ((a & 2u) << 3));
                        }
                    }
                } else {
                    const int k20 = (int)(uk >> kshv[qq]);
                    const u64 bg = __ballot(valid && k20 > tauv[qq]);
                    const u64 be = __ballot(valid && k20 == tauv[qq]);
                    Gm[qq] |= (bg & 0xffffffffull) << (32 * kb); Gm[2 + qq] |= (bg >> 32) << (32 * kb);
                    Em[qq] |= (be & 0xffffffffull) << (32 * kb); Em[2 + qq] |= (be >> 32) << (32 * kb);
                }
            }
        };
        auto finish_tile = [&](int kt) {
#pragma unroll
            for (int q = 0; q < 4; ++q) {
                u64 take = Em[q];
                const int neq = __popcll(take);
                if (cntq[q] + neq > rq[q]) {
                    int keep = rq[q] - cntq[q]; if (keep < 0) keep = 0;
                    while (__popcll(take) > keep) take &= ~(1ull << (63 - __clzll((long long)take)));
                }
                cntq[q] += neq;
                const u64 fin = Gm[q] | take;
                if (lane == q) bitmask[(size_t)(b * SEQ + t0 + 4 * wid + q) * 128 + kt] = fin;
            }
        };
        auto run_pass = [&](auto PASSC, const bool samp) {
            constexpr int PASS = decltype(PASSC)::value;
            if (PASS == 3) { cntA[0] = 0; cntA[1] = 0; }
            if (PASS != 2) {
#pragma unroll
                for (int j = 0; j < 8; ++j) *(u32x4*)(lds + wid * 8192 + j * 1024 + lane * 16) = (u32x4){0u, 0u, 0u, 0u};
            }
            u32x4 rg[4];
#pragma unroll
            for (int j = 0; j < 4; ++j) rg[j] = *(const u32x4*)(srcp + (size_t)(64 * j) * 64);
            __syncthreads();
#pragma unroll
            for (int j = 0; j < 4; ++j) *(u32x4*)(lds + st_off + j * 9216) = rg[j];
            __syncthreads();
            for (int st = 0; st < nst; ++st) {
                const unsigned bufo = (st & 1) * STAGE_B;
                if (st + 1 < nst) {
#pragma unroll
                    for (int j = 0; j < 4; ++j) rg[j] = *(const u32x4*)(srcp + (size_t)((st + 1) * 256 + 64 * j) * 64);
                }
                const int nsub = samp ? 1 : ((nt - 4 * st) < 4 ? (nt - 4 * st) : 4);
                f32x16 sA, sB;
                mma(sA, rd_off + bufo);
                for (int sub = 0; sub < nsub; ++sub) {
                    const int kt = 4 * st + sub, k0 = kt * 64;
                    const unsigned toff = rd_off + bufo + sub * 9216;
                    if (PASS == 2) {
#pragma unroll
                        for (int q = 0; q < 4; ++q) { Gm[q] = 0; Em[q] = 0; }
                    }
                    mma(sB, toff + 4608);
                    if (kt == nt - 1) proc(PASSC, IC<1>{}, sA, k0, 0); else proc(PASSC, IC<0>{}, sA, k0, 0);
                    if (sub + 1 < nsub) mma(sA, toff + 9216);
                    if (kt == nt - 1) proc(PASSC, IC<1>{}, sB, k0, 1); else proc(PASSC, IC<0>{}, sB, k0, 1);
                    if (PASS == 2) finish_tile(kt);
                }
                if (st + 1 < nst) {
#pragma unroll
                    for (int j = 0; j < 4; ++j) *(u32x4*)(lds + st_off + (STAGE_B - bufo) + j * 9216) = rg[j];
                }
                __syncthreads();
            }
            if (PASS != 2) {
                int ca0 = cntA[0], ca1 = cntA[1];
                if (PASS == 3) {
#pragma unroll
                    for (int d = 1; d < 32; d <<= 1) { ca0 += __shfl_xor(ca0, d); ca1 += __shfl_xor(ca1, d); }
                }
#pragma unroll
                for (int q = 0; q < 4; ++q) {
                    const int ql = 4 * wid + q;
                    int need = 256;
                    if (PASS == 0) need = samp ? 64 : 256;
                    else if (PASS == 1) need = info[ql * 4 + 1];
                    else need = 256 - __shfl((q & 1) ? ca1 : ca0, 32 * (q >> 1));
                    int bsel, above; bool hit;
                    if (PASS == 0 && samp) {
                        int bhi, blo, ab2; bool h2;
                        hist_select(hist + ql * 512, 32, lane, bhi, above, hit);
                        hist_select(hist + ql * 512, 128, lane, blo, ab2, h2);
                        if (!h2) blo = 0;
                        const int nb = bhi - blo + 1;
                        int sb = 8; while (sb > 0 && (nb << sb) > 1024) --sb;
                        if (lane == 0) { info[ql * 4 + 0] = blo; info[ql * 4 + 1] = bhi; info[160 + ql] = sb; if ((nb << sb) > 1024) info[128] = 1; }
                    } else {
                    hist_select(hist + ql * 512, need > 0 ? need : 1, lane, bsel, above, hit);
                    if (lane == 0) {
                        if (PASS == 0) { info[ql * 4 + 0] = bsel; info[ql * 4 + 1] = need - above; }
                        else if (PASS == 1) { info[ql * 4 + 2] = (info[ql * 4 + 0] << 10) | bsel; info[ql * 4 + 3] = need - above; info[160 + ql] = 10; }
                        else {
                            if (need <= 0 || !hit) info[128] = 1;
                            const int sb = info[160 + ql];
                            info[ql * 4 + 2] = ((info[ql * 4 + 0] + (bsel >> sb)) << sb) | (bsel & ((1 << sb) - 1)); info[ql * 4 + 3] = need - above;
                        }
                    }
                    }
                }
                __syncthreads();
#pragma unroll
                for (int qq = 0; qq < 2; ++qq) { const int ql = 4 * wid + 2 * hh + qq; b1v[qq] = info[ql * 4 + 0]; hiv[qq] = info[ql * 4 + 1]; tauv[qq] = info[ql * 4 + 2]; sbv[qq] = info[160 + ql]; kshv[qq] = 22 - sbv[qq]; }
#pragma unroll
                for (int q = 0; q < 4; ++q) { rq[q] = info[(4 * wid + q) * 4 + 3]; cntq[q] = 0; }
            }
        };
        bool have = false;
        if (nt >= 16) {
            if (tid == 0) info[128] = 0;
            run_pass(IC<0>{}, true);
            run_pass(IC<3>{}, false);
            if (info[128] == 0) have = true;
        }
        if (!have) { run_pass(IC<0>{}, false); run_pass(IC<1>{}, false); }
        run_pass(IC<2>{}, false);
        __syncthreads();
    }
}

DI void phase_final(const Params& p) {
    const int tid = threadIdx.x, lane = tid & 63, wid = tid >> 6;
    const float* sumsq = (const float*)(p.ws + WS_SUMSQ) + 4 * T_TOK;
    const float* g = p.in[17];
    float* out = p.out;
    f32x4 gg[4];
#pragma unroll
    for (int j = 0; j < 4; ++j) gg[j] = *(const f32x4*)(g + 4 * lane + 256 * j);
    for (int r0 = (blockIdx.x * 8 + wid) * 4; r0 < T_TOK; r0 += gridDim.x * 8 * 4) {
        f32x4 xv[4][4];
#pragma unroll
        for (int rr = 0; rr < 4; ++rr)
#pragma unroll
            for (int j = 0; j < 4; ++j) xv[rr][j] = *(const f32x4*)(out + (size_t)(r0 + rr) * 1024 + 4 * lane + 256 * j);
#pragma unroll
        for (int rr = 0; rr < 4; ++rr) {
            const float rstd = rsqrtf(sumsq[r0 + rr] * (1.0f / 1024.0f) + EPS);
#pragma unroll
            for (int j = 0; j < 4; ++j) {
                f32x4 v = xv[rr][j];
#pragma unroll
                for (int e = 0; e < 4; ++e) v[e] = v[e] * rstd * gg[j][e];
                *(f32x4*)(out + (size_t)(r0 + rr) * 1024 + 4 * lane + 256 * j) = v;
            }
        }
    }
}

DI void gbar(unsigned* ctr, unsigned& gen, unsigned G) {
    asm volatile("s_waitcnt vmcnt(0)" ::: "memory");
    __syncthreads();
    gen += 1;
    if (threadIdx.x == 0) {
        __builtin_amdgcn_fence(__ATOMIC_RELEASE, "agent");
        asm volatile("s_waitcnt vmcnt(0)" ::: "memory");
        __hip_atomic_fetch_add(ctr, 1u, __ATOMIC_RELAXED, __HIP_MEMORY_SCOPE_AGENT);
        while (__hip_atomic_load(ctr, __ATOMIC_RELAXED, __HIP_MEMORY_SCOPE_AGENT) < gen * G) __builtin_amdgcn_s_sleep(1);
        __builtin_amdgcn_fence(__ATOMIC_ACQUIRE, "agent");
        asm volatile("s_waitcnt vmcnt(0)" ::: "memory");
    }
    __syncthreads();
}

__global__ void __launch_bounds__(NTHREADS) fwd_megakernel(Params p) {
    extern __shared__ __attribute__((aligned(16))) unsigned char lds[];
    cg::grid_group grid = cg::this_grid();
    unsigned char* ws = p.ws;
    float* sumsq = (float*)(ws + WS_SUMSQ);
    bf16_t* hb = (bf16_t*)(ws + WS_HB);
    bf16_t* pbuf = (bf16_t*)(ws + WS_PBUF);
    bf16_t* vt = (bf16_t*)(ws + WS_VT);
    bf16_t* mixed = (bf16_t*)(ws + WS_MIXED);
    bf16_t* U = (bf16_t*)(ws + WS_PBUF);
    const float* rope = (const float*)(ws + WS_ROPE);
#define PH(k) if (p.ph_lo <= (k) && (k) < p.ph_hi)
    unsigned bgen = 0; unsigned* bctr = (unsigned*)(ws + WS_BAR);
#define SYNC(k) if (p.ph_lo <= (k) && (k) + 1 < p.ph_hi) { if ((k) == 0) grid.sync(); else gbar(bctr, bgen, gridDim.x); }
#define GEMM(EPI, e, A_, W_, N_, K_) { pg8::Gemm g{A_, W_, T_TOK, N_, K_}; pg8::StaticOrder S; S.init(T_TOK, N_, (int)gridDim.x, (int)blockIdx.x); \
        pg8::gemm_phase<EPI, pg8::StaticOrder, true, true>(l3, g, S, e); }
    PG8_LAS unsigned char* l3 = (PG8_LAS unsigned char*)lds;
    PH(0) phase_prep(p, lds);
    if (REP_PH == 0) PH(0) phase_prep(p, lds);
    SYNC(0)
    PH(1) { EpiProj0b e{sumsq, pbuf, vt, vt + (size_t)4 * 512 * SEQ, (float*)(ws + WS_LOGF), p.in[3], rope}; GEMM(EpiProj0b, e, hb, (const bf16_t*)(ws + WS_WT_IN0), 3072, 1024) }
    if (REP_PH == 1) PH(1) { EpiProj0b e{sumsq, pbuf, vt, vt + (size_t)4 * 512 * SEQ, (float*)(ws + WS_LOGF), p.in[3], rope}; GEMM(EpiProj0b, e, hb, (const bf16_t*)(ws + WS_WT_IN0), 3072, 1024) }
    SYNC(1)
    PH(2) phase_scan(p, lds);
    if (REP_PH == 2) PH(2) phase_scan(p, lds);
    SYNC(2)
    PH(3) { attn_phase<0>(p, lds); attn_phase<1>(p, lds); }
    if (REP_PH == 3) PH(3) { attn_phase<0>(p, lds); attn_phase<1>(p, lds); }
    SYNC(3)
    PH(4) { EpiRes2 e{p.in[0], p.out, hb, sumsq + T_TOK, nullptr}; GEMM(EpiRes2, e, mixed, (const bf16_t*)(ws + WS_WT_OUT0), 1024, 1024) }
    SYNC(4)
    PH(5) { EpiUp2 e{sumsq + T_TOK, U}; GEMM(EpiUp2, e, hb, (const bf16_t*)(ws + WS_WT_UP0), 4096, 1024) }
    if (REP_PH == 5) PH(5) { EpiUp2 e{sumsq + T_TOK, U}; GEMM(EpiUp2, e, hb, (const bf16_t*)(ws + WS_WT_UP0), 4096, 1024) }
    SYNC(5)
    PH(6) { EpiRes2 e{p.out, p.out, hb, sumsq + 2 * T_TOK, sumsq + T_TOK}; GEMM(EpiRes2, e, U, (const bf16_t*)(ws + WS_WT_DN0), 1024, 4096) }
    SYNC(6)
    PH(7) { EpiProj1b e{sumsq + 2 * T_TOK, pbuf, vt, (float*)(ws + WS_BITMASK), (float*)(ws + WS_IW), rope}; GEMM(EpiProj1b, e, hb, (const bf16_t*)(ws + WS_WT_IN1), 3840, 1024) }
    if (REP_PH == 7) PH(7) { EpiProj1b e{sumsq + 2 * T_TOK, pbuf, vt, (float*)(ws + WS_BITMASK), (float*)(ws + WS_IW), rope}; GEMM(EpiProj1b, e, hb, (const bf16_t*)(ws + WS_WT_IN1), 3840, 1024) }
    SYNC(7)
    PH(8) phase_iknorm(p);
    if (REP_PH == 200) { for (int i_ = 0; i_ < 10; ++i_) grid.sync(); }
    SYNC(8)
    PH(9) phase_index(p, lds);
    if (REP_PH == 9) PH(9) phase_index(p, lds);
    SYNC(9)
    if (REP_PH == 110) PH(10) attn_phase<2, 1>(p, lds);
    PH(10) attn_phase<2>(p, lds);
    if (REP_PH == 10) PH(10) attn_phase<2>(p, lds);
    SYNC(10)
    PH(11) { EpiRes2 e{p.out, p.out, hb, sumsq + 3 * T_TOK, nullptr}; GEMM(EpiRes2, e, mixed, (const bf16_t*)(ws + WS_WT_OUT1), 1024, 1024) }
    SYNC(11)
    PH(12) { EpiUp2 e{sumsq + 3 * T_TOK, U}; GEMM(EpiUp2, e, hb, (const bf16_t*)(ws + WS_WT_UP1), 4096, 1024) }
    SYNC(12)
    PH(13) { EpiRes2 e{p.out, p.out, nullptr, sumsq + 4 * T_TOK, sumsq + 3 * T_TOK}; GEMM(EpiRes2, e, U, (const bf16_t*)(ws + WS_WT_DN1), 1024, 4096) }
    SYNC(13)
    PH(14) phase_final(p);
}

extern "C" void kernel_launch(void* const* d_in, const int* in_sizes, int n_in, void* d_out, int out_size, void* d_ws, size_t ws_size, hipStream_t stream) {
    static int grid_blocks = 0;
    if (grid_blocks == 0) {
        if (n_in != 18 || ws_size < WS_END) { fprintf(stderr, "kernel_launch: unexpected n_in %d / ws_size %zu (need %zu)\n", n_in, ws_size, (size_t)WS_END); grid_blocks = -1; return; }
        int dev = 0, cus = 0, per_cu = 0;
        hipGetDevice(&dev);
        hipDeviceGetAttribute(&cus, hipDeviceAttributeMultiprocessorCount, dev);
        hipFuncSetAttribute((const void*)fwd_megakernel, hipFuncAttributeMaxDynamicSharedMemorySize, LDS_BYTES);
        hipOccupancyMaxActiveBlocksPerMultiprocessor(&per_cu, (const void*)fwd_megakernel, NTHREADS, LDS_BYTES);
        if (per_cu < 1) { fprintf(stderr, "kernel_launch: occupancy query says %d blocks/CU\n", per_cu); per_cu = 1; }
        (void)hipGetLastError();
        grid_blocks = cus;
    }
    if (grid_blocks < 0) return;
    Params p{};
    for (int i = 0; i < 18; ++i) p.in[i] = (const float*)d_in[i];
    p.out = (float*)d_out; p.ws = (unsigned char*)d_ws;
    for (int i = 0; i < 8; ++i) p.inv_freq[i] = (float)pow(500000.0, -(2.0 * i) / 16.0);
    p.ph_lo = 0; p.ph_hi = 15;
    void* args[] = {&p};
    hipError_t e = hipLaunchCooperativeKernel((const void*)fwd_megakernel, dim3(grid_blocks), dim3(NTHREADS), args, LDS_BYTES, stream);
    if (e != hipSuccess) fprintf(stderr, "cooperative launch failed: %s (grid %d)\n", hipGetErrorString(e), grid_blocks);
}
```

```cpp
#include <hip/hip_runtime.h>
#include <hip/hip_cooperative_groups.h>
#include <cstdint>
#include <cstdio>
#include <cmath>
namespace cg = cooperative_groups;

typedef unsigned short bf16_t;
typedef short bf16x8 __attribute__((ext_vector_type(8)));
typedef short s16x4 __attribute__((ext_vector_type(4)));
typedef float f32x16 __attribute__((ext_vector_type(16)));
typedef float f32x4 __attribute__((ext_vector_type(4)));
typedef float f32x2 __attribute__((ext_vector_type(2)));
typedef unsigned u32x4 __attribute__((ext_vector_type(4)));
typedef unsigned u32x2 __attribute__((ext_vector_type(2)));
typedef __bf16 bf2_t __attribute__((ext_vector_type(2)));
typedef unsigned long long u64;

#define DI __device__ __forceinline__
#define MFMA32(a, b, c) __builtin_amdgcn_mfma_f32_32x32x16_bf16((a), (b), (c), 0, 0, 0)

constexpr int T_TOK = 32768, SEQ = 8192, DM = 1024, NTHREADS = 512;
constexpr float EPS = 1e-6f;
constexpr float QSCALE = 0.125f * 1.4426950408889634f;
constexpr float LOG2E = 1.4426950408889634f;
constexpr int P0_PITCH = 3072, P1_PITCH = 3584;

constexpr size_t WS_WT_IN0 = 0;
constexpr size_t WS_WT_OUT0 = WS_WT_IN0 + (size_t)3328 * 1024 * 2;
constexpr size_t WS_WT_IN1 = WS_WT_OUT0 + (size_t)1024 * 1024 * 2;
constexpr size_t WS_WT_OUT1 = WS_WT_IN1 + (size_t)3840 * 1024 * 2;
constexpr size_t WS_WT_UP0 = WS_WT_OUT1 + (size_t)1024 * 1024 * 2;
constexpr size_t WS_WT_UP1 = WS_WT_UP0 + (size_t)4096 * 1024 * 2;
constexpr size_t WS_WT_DN0 = WS_WT_UP1 + (size_t)4096 * 1024 * 2;
constexpr size_t WS_WT_DN1 = WS_WT_DN0 + (size_t)4096 * 1024 * 2;
constexpr size_t WS_HB = WS_WT_DN1 + (size_t)4096 * 1024 * 2;
constexpr size_t WS_PBUF = WS_HB + (size_t)T_TOK * 1024 * 2;
constexpr size_t WS_VT = WS_PBUF + (size_t)T_TOK * 3584 * 2;
constexpr size_t WS_MIXED = WS_VT + (size_t)T_TOK * 1024 * 2;
constexpr size_t WS_BITMASK = WS_MIXED + (size_t)T_TOK * 1024 * 2;
constexpr size_t WS_IKB = WS_BITMASK + (size_t)T_TOK * 128 * 8;
constexpr size_t WS_IW = WS_IKB + (size_t)T_TOK * 64 * 2;
constexpr size_t WS_LOGF = WS_IW + (size_t)T_TOK * 8 * 4;
constexpr size_t WS_C2 = WS_LOGF + (size_t)T_TOK * 8 * 4;
constexpr size_t WS_SUMSQ = WS_C2 + (size_t)T_TOK * 8 * 4;
constexpr size_t WS_ROPE = WS_SUMSQ + (size_t)5 * T_TOK * 4;
constexpr size_t WS_BND = WS_ROPE + (size_t)SEQ * 16 * 4;
constexpr size_t WS_BAR = WS_BND + 256;
constexpr size_t WS_END = WS_BAR + 256;
static_assert(WS_END <= (size_t)536870912, "workspace too large");
static_assert((size_t)T_TOK * 4096 * 2 <= WS_MIXED - WS_PBUF, "U overlay too large");

constexpr int LDS_BYTES = 140288;
constexpr int REP_PH = -1;

struct Params {
    const float* in[18];
    float* out;
    unsigned char* ws;
    float inv_freq[8];
    int ph_lo, ph_hi;
};

DI unsigned pk_bf16(float a, float b) { f32x2 v = {a, b}; bf2_t r = __builtin_convertvector(v, bf2_t); return __builtin_bit_cast(unsigned, r); }
DI bf16_t to_bf16(float a) { return (bf16_t)(pk_bf16(a, 0.f) & 0xffffu); }
DI void store4_bf16(bf16_t* p, float a, float b, float c, float d) { u32x2 w; w.x = pk_bf16(a, b); w.y = pk_bf16(c, d); *(u32x2*)p = w; }
DI int crow(int i, int hh) { return (i & 3) + 8 * (i >> 2) + 4 * hh; }
DI float xhalf_sum(float v) { const auto r = __builtin_amdgcn_permlane32_swap(__float_as_uint(v), __float_as_uint(v), false, false); return __uint_as_float(r[0]) + __uint_as_float(r[1]); }
DI float xhalf_max(float v) { const auto r = __builtin_amdgcn_permlane32_swap(__float_as_uint(v), __float_as_uint(v), false, false); return fmaxf(__uint_as_float(r[0]), __uint_as_float(r[1])); }
DI float wave_sum(float v) {
#pragma unroll
    for (int d = 32; d >= 1; d >>= 1) v += __shfl_xor(v, d);
    return v;
}

struct TJob { const float* W; int K, N; const float* gain; bf16_t* dst; int k0, n0; };

DI TJob tjob_decode(const Params& p, int t) {
    unsigned char* ws = p.ws;
    TJob j; int Npad; int tt = t;
    if (tt < 384) { j.W = p.in[2]; j.K = 1024; j.N = 3080; Npad = 3072; j.gain = p.in[1]; j.dst = (bf16_t*)(ws + WS_WT_IN0); }
    else if ((tt -= 384) < 128) { j.W = p.in[9]; j.K = 1024; j.N = 1024; Npad = 1024; j.gain = nullptr; j.dst = (bf16_t*)(ws + WS_WT_OUT0); }
    else if ((tt -= 128) < 480) { j.W = p.in[10]; j.K = 1024; j.N = 3656; Npad = 3840; j.gain = p.in[1] + 1024; j.dst = (bf16_t*)(ws + WS_WT_IN1); }
    else if ((tt -= 480) < 128) { j.W = p.in[13]; j.K = 1024; j.N = 1024; Npad = 1024; j.gain = nullptr; j.dst = (bf16_t*)(ws + WS_WT_OUT1); }
    else if ((tt -= 128) < 512) { j.W = p.in[15]; j.K = 1024; j.N = 4096; Npad = 4096; j.gain = p.in[14]; j.dst = (bf16_t*)(ws + WS_WT_UP0); }
    else if ((tt -= 512) < 512) { j.W = p.in[15] + (size_t)1024 * 4096; j.K = 1024; j.N = 4096; Npad = 4096; j.gain = p.in[14] + 1024; j.dst = (bf16_t*)(ws + WS_WT_UP1); }
    else if ((tt -= 512) < 512) { j.W = p.in[16]; j.K = 4096; j.N = 1024; Npad = 1024; j.gain = nullptr; j.dst = (bf16_t*)(ws + WS_WT_DN0); }
    else { tt -= 512; j.W = p.in[16] + (size_t)4096 * 1024; j.K = 4096; j.N = 1024; Npad = 1024; j.gain = nullptr; j.dst = (bf16_t*)(ws + WS_WT_DN1); }
    const int ntn = Npad >> 7;
    j.k0 = (tt / ntn) * 64; j.n0 = (tt % ntn) * 128;
    return j;
}

DI void tjob_load(const TJob& j, float (&v)[16]) {
    const int tid = threadIdx.x;
#pragma unroll
    for (int i = 0; i < 16; ++i) {
        const int idx = tid + 512 * i, kk = idx >> 7, nn = idx & 127;
        v[i] = (j.n0 + nn < j.N) ? j.W[(size_t)(j.k0 + kk) * j.N + j.n0 + nn] : 0.f;
    }
    if (j.gain) {
#pragma unroll
        for (int i = 0; i < 16; ++i) v[i] *= j.gain[j.k0 + ((tid + 512 * i) >> 7)];
    }
}

DI void phase_prep(const Params& p, unsigned char* lds) {
    float* ldsf = (float*)lds;
    unsigned char* ws = p.ws;
    {
        const int tid = threadIdx.x;
        int t = blockIdx.x;
        float v[16];
        TJob cur{};
        if (t < 3168) { cur = tjob_decode(p, t); tjob_load(cur, v); }
        while (t < 3168) {
#pragma unroll
            for (int i = 0; i < 16; ++i) { const int idx = tid + 512 * i, kk = idx >> 7, nn = idx & 127; ldsf[nn * 65 + kk] = v[i]; }
            __syncthreads();
            const int tn = t + (int)gridDim.x;
            TJob nxt = cur;
            if (tn < 3168) { nxt = tjob_decode(p, tn); tjob_load(nxt, v); }
#pragma unroll
            for (int i = 0; i < 8; ++i) {
                const int idx = tid + 512 * i, nn = idx >> 5, kp = (idx & 31) * 2;
                *(unsigned*)(cur.dst + (size_t)(cur.n0 + nn) * cur.K + cur.k0 + kp) = pk_bf16(ldsf[nn * 65 + kp], ldsf[nn * 65 + kp + 1]);
            }
            __syncthreads();
            cur = nxt; t = tn;
        }
    }
    const int tid = threadIdx.x, lane = tid & 63, wid = tid >> 6;
    const float* x = p.in[0];
    bf16_t* hb = (bf16_t*)(ws + WS_HB);
    float* sumsq = (float*)(ws + WS_SUMSQ);
    for (int r0 = (blockIdx.x * 8 + wid) * 4; r0 < T_TOK; r0 += gridDim.x * 8 * 4) {
        f32x4 xv[4][4];
#pragma unroll
        for (int rr = 0; rr < 4; ++rr)
#pragma unroll
            for (int j = 0; j < 4; ++j) xv[rr][j] = *(const f32x4*)(x + (size_t)(r0 + rr) * 1024 + 4 * lane + 256 * j);
        float ssr[4];
#pragma unroll
        for (int rr = 0; rr < 4; ++rr) {
            const int row = r0 + rr; float ss = 0.f;
#pragma unroll
            for (int j = 0; j < 4; ++j) {
                const f32x4 v = xv[rr][j];
                ss += v[0] * v[0] + v[1] * v[1] + v[2] * v[2] + v[3] * v[3];
                store4_bf16(hb + (size_t)row * 1024 + 4 * lane + 256 * j, v[0], v[1], v[2], v[3]);
            }
            ss = wave_sum(ss); ssr[rr] = ss;
            if (lane == 0) { sumsq[row] = ss; sumsq[T_TOK + row] = 0.f; sumsq[2 * T_TOK + row] = 0.f; sumsq[3 * T_TOK + row] = 0.f; sumsq[4 * T_TOK + row] = 0.f; }
        }
        float a[32];
#pragma unroll
        for (int i = 0; i < 32; ++i) a[i] = 0.f;
        const float* Wl = p.in[2] + 3072; const float* gmix = p.in[1];
#pragma unroll
        for (int j = 0; j < 4; ++j) {
            const f32x4 g4 = *(const f32x4*)(gmix + 4 * lane + 256 * j);
#pragma unroll
            for (int e = 0; e < 4; ++e) {
                const size_t k = (size_t)(4 * lane + 256 * j + e);
                const f32x4 w0 = *(const f32x4*)(Wl + k * 3080), w1 = *(const f32x4*)(Wl + k * 3080 + 4);
#pragma unroll
                for (int rr = 0; rr < 4; ++rr) {
                    const float xk = xv[rr][j][e] * g4[e];
#pragma unroll
                    for (int c = 0; c < 4; ++c) { a[rr * 8 + c] += xk * w0[c]; a[rr * 8 + 4 + c] += xk * w1[c]; }
                }
            }
        }
        float b16[16], b8[8], b4[4], b2[2];
        { const bool bt = (lane & 32) != 0;
#pragma unroll
          for (int i = 0; i < 16; ++i) { const float snd = bt ? a[i] : a[i + 16], kp = bt ? a[i + 16] : a[i]; b16[i] = kp + __shfl_xor(snd, 32); } }
        { const bool bt = (lane & 16) != 0;
#pragma unroll
          for (int i = 0; i < 8; ++i) { const float snd = bt ? b16[i] : b16[i + 8], kp = bt ? b16[i + 8] : b16[i]; b8[i] = kp + __shfl_xor(snd, 16); } }
        { const bool bt = (lane & 8) != 0;
#pragma unroll
          for (int i = 0; i < 4; ++i) { const float snd = bt ? b8[i] : b8[i + 4], kp = bt ? b8[i + 4] : b8[i]; b4[i] = kp + __shfl_xor(snd, 8); } }
        { const bool bt = (lane & 4) != 0;
#pragma unroll
          for (int i = 0; i < 2; ++i) { const float snd = bt ? b4[i] : b4[i + 2], kp = bt ? b4[i + 2] : b4[i]; b2[i] = kp + __shfl_xor(snd, 4); } }
        float tot;
        { const bool bt = (lane & 2) != 0; const float snd = bt ? b2[0] : b2[1], kp = bt ? b2[1] : b2[0]; tot = kp + __shfl_xor(snd, 2); }
        tot += __shfl_xor(tot, 1);
        {
            const int rr = lane >> 4, c = (lane >> 1) & 7;
            const float ssm = (rr == 0) ? ssr[0] : ((rr == 1) ? ssr[1] : ((rr == 2) ? ssr[2] : ssr[3]));
            const float v = tot * rsqrtf(ssm * (1.0f / 1024.0f) + EPS) + p.in[3][c];
            if ((lane & 1) == 0) ((float*)(ws + WS_LOGF))[(size_t)(r0 + rr) * 8 + c] = fminf(v, 0.f) - __logf(1.0f + __expf(-fabsf(v)));
        }
    }
    if (blockIdx.x == 0 && threadIdx.x < 64) { ((unsigned*)(ws + WS_BND))[threadIdx.x] = 0u; ((unsigned*)(ws + WS_BAR))[threadIdx.x] = 0u; }
    float* rope = (float*)(ws + WS_ROPE);
    for (int e = blockIdx.x * NTHREADS + tid; e < SEQ * 8; e += gridDim.x * NTHREADS) {
        const int s = e >> 3, i = e & 7;
        const float ang = (float)s * p.inv_freq[i];
        const double a = (double)ang; const double k = rint(a * 0.15915494309189535); const double r = a - k * 6.283185307179586;
        const float rf = (float)r;
        rope[s * 16 + i] = __cosf(rf); rope[s * 16 + 8 + i] = __sinf(rf);
    }
}

namespace pg8 {
#define PG8_LAS __attribute__((address_space(3)))
typedef unsigned short bf16_t;
typedef short bf16x8 __attribute__((ext_vector_type(8)));
typedef float f32x4 __attribute__((ext_vector_type(4)));
typedef unsigned u32x4 __attribute__((ext_vector_type(4)));
constexpr int BM = 256, BK = 64, HALF = 128, HTB = HALF * BK * 2  , STAGE_BYTES = 8 * HTB, NXCD = 8, WGM = 8;

__host__ __device__ __forceinline__ int lds_byte(int r, int c) { const int st = (r >> 4) * 2 + (c >> 5), rr = r & 15, cc = c & 31, ob = rr * 64 + cc * 2; return st * 1024 + (ob ^ (((ob >> 9) & 1) << 5)); }
__host__ __device__ __forceinline__ void stage_rc(int b, int& R, int& C) { const int st = b / 1024, sb = b % 1024, swz = sb ^ (((sb >> 9) & 1) << 5); R = (st >> 1) * 16 + swz / 64; C = (st & 1) * 32 + (swz % 64) / 2; }
__host__ __device__ __forceinline__ int perm32(int rho) { const int n = rho >> 4, i = rho & 15; return 8 * (i >> 2) + 4 * n + (i & 3); }

struct Unit { int pm, pn; };
struct Gemm { const bf16_t* A; const bf16_t* Bt; int M, N, K; };

struct StaticOrder {
    int nM, nN, nwg, G, c;
    __host__ __device__ void init(int M, int N, int G_, int c_) { nM = M / BM; nN = N / BM; nwg = nM * nN; G = G_; c = c_; }
    __host__ __device__ bool next(int i, Unit& u) const {
        const long L = (long)i * G + c; if (L >= nwg) return false;
        int wgid = (int)L; { const int q = nwg / NXCD, r = nwg % NXCD, xcd = wgid % NXCD, off = wgid / NXCD; wgid = (xcd < r ? xcd * (q + 1) : r * (q + 1) + (xcd - r) * q) + off; }
        const int nig = WGM * nN, gid = wgid / nig, fm = gid * WGM, gsz = (nM - fm) < WGM ? (nM - fm) : WGM;
        u.pm = fm + ((wgid % nig) % gsz); u.pn = (wgid % nig) / gsz; return true;
    }
    __device__ __forceinline__ void a_ready(const Unit&) const {}
    __device__ __forceinline__ void done(const Unit&) const {}
};
__device__ __forceinline__ unsigned cvt_pk_bf16(float lo, float hi) { unsigned r; asm volatile("v_cvt_pk_bf16_f32 %0, %1, %2" : "=v"(r) : "v"(lo), "v"(hi)); return r; }
typedef float f32x2 __attribute__((ext_vector_type(2)));
template <class Epi, class Sched, bool ALIGN_EPI = false, bool SP2 = false>
__device__ __forceinline__ void gemm_phase(PG8_LAS unsigned char* lds, const Gemm g, const Sched& S, const Epi& E) {
    const int tid = threadIdx.x, wid = __builtin_amdgcn_readfirstlane(tid >> 6), lane = tid & 63, wr = wid >> 2, wc = wid & 3, fr = lane & 15, fq = lane >> 4;
    const int K = g.K, nt = K / BK;
    unsigned voffA[2], voffB[2];
#pragma unroll
    for (int i = 0; i < 2; ++i) { int R, C; stage_rc(tid * 16 + i * 8192, R, C); const int Rb = Epi::PERM ? ((R & ~31) + perm32(R & 31)) : R;
        voffA[i] = (unsigned)(R * K + C) * 2u; voffB[i] = (unsigned)(Rb * K + C) * 2u; }
    const size_t kstep = (size_t)(BK * 2);
    const size_t hstep = (size_t)HALF * K * 2;
    const size_t tstep = 2 * hstep;
    const unsigned ldsw = (unsigned)wid * 1024u;
    const int aoff = lds_byte(wr * 64 + fr, fq * 8), boff = lds_byte(wc * 32 + fr, fq * 8);
#define PG8_SA(b, h) (((b) * 2 + (h)) * HTB)
#define PG8_SB(b, h) ((4 + (b) * 2 + (h)) * HTB)
#define PG8_STAGE(bufoff, gbase, voff) do { _Pragma("unroll") for (int _i = 0; _i < 2; ++_i) \
        __builtin_amdgcn_global_load_lds((const unsigned*)((const char*)(gbase) + (voff)[_i]), (PG8_LAS unsigned*)(lds + (bufoff) + ldsw + _i * 8192), 16, 0, 0); } while (0)
#define PG8_LDA(dst, b, h) do { _Pragma("unroll") for (int m = 0; m < 4; ++m) _Pragma("unroll") for (int k = 0; k < 2; ++k) dst[m][k] = *(const PG8_LAS bf16x8*)(lds + PG8_SA(b, h) + aoff + m * 2048 + k * 1024); } while (0)
#define PG8_LDB(dst, b, h) do { _Pragma("unroll") for (int n = 0; n < 2; ++n) _Pragma("unroll") for (int k = 0; k < 2; ++k) dst[n][k] = *(const PG8_LAS bf16x8*)(lds + PG8_SB(b, h) + boff + n * 2048 + k * 1024); } while (0)
#define PG8_MMA(ai, bj, At, Bt) do { __builtin_amdgcn_s_setprio(1); _Pragma("unroll") for (int m = 0; m < 4; ++m) _Pragma("unroll") for (int n = 0; n < 2; ++n) _Pragma("unroll") for (int k = 0; k < 2; ++k) \
        acc[ai][bj][m][n] = __builtin_amdgcn_mfma_f32_16x16x32_bf16(Bt[n][k], At[m][k], acc[ai][bj][m][n], 0, 0, 0); __builtin_amdgcn_s_setprio(0); } while (0)
#define PG8_WAIT_V(n) asm volatile("s_waitcnt vmcnt(" #n ")" ::: "memory")
#define PG8_WAIT_L(n) asm volatile("s_waitcnt lgkmcnt(" #n ")" ::: "memory")
#define PG8_BAR __builtin_amdgcn_s_barrier()
#define PG8_SCHED __builtin_amdgcn_sched_barrier(0)
    Unit cur, nxt; int ui = 0;
    if (!S.next(0, cur)) return;
    f32x4 acc[2][2][4][2];
#pragma unroll
    for (int a = 0; a < 2; ++a)
#pragma unroll
        for (int b = 0; b < 2; ++b)
#pragma unroll
            for (int m = 0; m < 4; ++m)
#pragma unroll
                for (int n = 0; n < 2; ++n) acc[a][b][m][n] = (f32x4){0.f, 0.f, 0.f, 0.f};
    bf16x8 At[4][2], B0[2][2], B1[2][2];
    const char* cA = (const char*)g.A + (size_t)cur.pm * tstep; const char* cB = (const char*)g.Bt + (size_t)cur.pn * tstep;
    S.a_ready(cur);
    if constexpr (SP2) {
        PG8_STAGE(PG8_SB(0, 0), cB, voffB); PG8_STAGE(PG8_SB(0, 1), cB + hstep, voffB); PG8_STAGE(PG8_SA(0, 0), cA, voffA); PG8_STAGE(PG8_SA(0, 1), cA + hstep, voffA);
        if (wr == 1) PG8_BAR;
        PG8_WAIT_V(2); PG8_BAR;
        PG8_STAGE(PG8_SB(1, 0), cB + kstep, voffB); PG8_STAGE(PG8_SA(1, 0), cA + kstep, voffA); PG8_STAGE(PG8_SB(1, 1), cB + hstep + kstep, voffB);
        PG8_WAIT_V(6); PG8_BAR;
    } else {
        PG8_STAGE(PG8_SB(0, 0), cB, voffB); PG8_STAGE(PG8_SA(0, 0), cA, voffA); PG8_STAGE(PG8_SB(0, 1), cB + hstep, voffB); PG8_STAGE(PG8_SA(0, 1), cA + hstep, voffA);
        if (wr == 1) PG8_BAR;
        PG8_WAIT_V(4); PG8_BAR;
        PG8_STAGE(PG8_SB(1, 0), cB + kstep, voffB); PG8_STAGE(PG8_SA(1, 0), cA + kstep, voffA); PG8_STAGE(PG8_SB(1, 1), cB + hstep + kstep, voffB);
        PG8_WAIT_V(6); PG8_BAR;
    }
    for (;;) {
        const bool has_next = S.next(ui + 1, nxt);
        const char* nA = has_next ? (const char*)g.A + (size_t)nxt.pm * tstep : cA; const char* nB = has_next ? (const char*)g.Bt + (size_t)nxt.pn * tstep : cB;
        for (int t = 0; t < nt; t += 2) {
            const bool last = (t == nt - 2);
            const char* a1 = cA + (size_t)(t + 1) * kstep;
            const char* a2 = last ? nA : cA + (size_t)(t + 2) * kstep; const char* b2 = last ? nB : cB + (size_t)(t + 2) * kstep;
            const char* a3 = a2 + kstep; const char* b3 = b2 + kstep;
            if (last && has_next) S.a_ready(nxt);
            if constexpr (SP2) {
            PG8_LDB(B0, 0, 0); PG8_LDB(B1, 0, 1); PG8_SCHED; PG8_LDA(At, 0, 0); PG8_STAGE(PG8_SA(1, 1), a1 + hstep, voffA);
            PG8_WAIT_V(8); PG8_WAIT_L(0); PG8_BAR; PG8_MMA(0, 0, At, B0); PG8_MMA(0, 1, At, B1); PG8_BAR; PG8_SCHED;
            PG8_LDA(At, 0, 1); PG8_STAGE(PG8_SB(0, 0), b2, voffB); PG8_STAGE(PG8_SB(0, 1), b2 + hstep, voffB); PG8_STAGE(PG8_SA(0, 0), a2, voffA);
            PG8_WAIT_V(8); PG8_WAIT_L(0); PG8_BAR; PG8_MMA(1, 0, At, B0); PG8_MMA(1, 1, At, B1); PG8_BAR; PG8_SCHED;
            PG8_LDB(B0, 1, 0); PG8_LDB(B1, 1, 1); PG8_SCHED; PG8_LDA(At, 1, 0); PG8_STAGE(PG8_SA(0, 1), a2 + hstep, voffA);
            PG8_WAIT_V(8); PG8_WAIT_L(0); PG8_BAR; PG8_MMA(0, 0, At, B0); PG8_MMA(0, 1, At, B1); PG8_BAR; PG8_SCHED;
            PG8_LDA(At, 1, 1); PG8_STAGE(PG8_SB(1, 0), b3, voffB); PG8_STAGE(PG8_SB(1, 1), b3 + hstep, voffB); PG8_STAGE(PG8_SA(1, 0), a3, voffA);
            PG8_WAIT_V(8); PG8_WAIT_L(0); PG8_BAR; PG8_MMA(1, 0, At, B0); PG8_MMA(1, 1, At, B1); PG8_BAR; PG8_SCHED;
            } else {
            PG8_LDB(B0, 0, 0); PG8_SCHED; PG8_LDA(At, 0, 0); PG8_STAGE(PG8_SA(1, 1), a1 + hstep, voffA);
            PG8_WAIT_L(8); PG8_BAR; PG8_WAIT_L(0); PG8_MMA(0, 0, At, B0); PG8_BAR; PG8_SCHED;
            PG8_LDB(B1, 0, 1); PG8_STAGE(PG8_SB(0, 0), b2, voffB);
            PG8_BAR; PG8_WAIT_L(0); PG8_MMA(0, 1, At, B1); PG8_BAR;
            PG8_LDA(At, 0, 1); PG8_STAGE(PG8_SA(0, 0), a2, voffA);
            PG8_BAR; PG8_WAIT_L(0); PG8_MMA(1, 0, At, B0); PG8_BAR; PG8_SCHED;
            PG8_STAGE(PG8_SB(0, 1), b2 + hstep, voffB);
            PG8_WAIT_V(6); PG8_BAR; PG8_MMA(1, 1, At, B1); PG8_BAR;
            PG8_LDB(B0, 1, 0); PG8_SCHED; PG8_LDA(At, 1, 0); PG8_STAGE(PG8_SA(0, 1), a2 + hstep, voffA);
            PG8_WAIT_L(8); PG8_BAR; PG8_WAIT_L(0); PG8_MMA(0, 0, At, B0); PG8_BAR; PG8_SCHED;
            PG8_LDB(B1, 1, 1); PG8_STAGE(PG8_SB(1, 0), b3, voffB);
            PG8_BAR; PG8_WAIT_L(0); PG8_MMA(0, 1, At, B1); PG8_BAR;
            PG8_LDA(At, 1, 1); PG8_STAGE(PG8_SA(1, 0), a3, voffA);
            PG8_BAR; PG8_WAIT_L(0); PG8_MMA(1, 0, At, B0); PG8_BAR; PG8_SCHED;
            PG8_STAGE(PG8_SB(1, 1), b3 + hstep, voffB);
            PG8_WAIT_V(6); PG8_BAR; PG8_MMA(1, 1, At, B1); PG8_BAR;
            }
        }
        if constexpr (ALIGN_EPI) { if (wr == 0) PG8_BAR; }
        if constexpr (!Epi::AFTER_DRAIN) { E(acc, cur, wr, wc, fr, fq); S.done(cur); }
        if (!has_next) break;
#pragma unroll
        for (int a = 0; a < 2; ++a)
#pragma unroll
            for (int b = 0; b < 2; ++b)
#pragma unroll
                for (int m = 0; m < 4; ++m)
#pragma unroll
                    for (int n = 0; n < 2; ++n) acc[a][b][m][n] = (f32x4){0.f, 0.f, 0.f, 0.f};
        cur = nxt; cA = nA; cB = nB; ++ui;
        if constexpr (ALIGN_EPI) { if (wr == 1) PG8_BAR; }
    }
    PG8_WAIT_V(0);
    if constexpr (!ALIGN_EPI) { if (wr == 0) PG8_BAR; }
    PG8_BAR;
    if constexpr (Epi::AFTER_DRAIN) { E.fused(acc, cur, wr, wc, fr, fq, lds, wid, lane); S.done(cur); }
#undef PG8_SA
#undef PG8_SB
#undef PG8_STAGE
#undef PG8_LDA
#undef PG8_LDB
#undef PG8_MMA
#undef PG8_WAIT_V
#undef PG8_WAIT_L
#undef PG8_BAR
#undef PG8_SCHED
}
}

struct EpiUp2 {
    static constexpr bool PERM = true, AFTER_DRAIN = false;
    const float* sumsq; bf16_t* U;
    DI void operator()(const pg8::f32x4 (&acc)[2][2][4][2], const pg8::Unit& u, int wr, int wc, int fr, int fq) const {
        const int row0 = u.pm * 256 + wr * 64 + fr, col0 = u.pn * 256 + wc * 32 + 8 * fq;
#pragma unroll
        for (int ai = 0; ai < 2; ++ai)
#pragma unroll
            for (int m = 0; m < 4; ++m) {
                const int row = row0 + ai * 128 + m * 16;
                bf16_t* rp = U + (size_t)row * 4096 + col0;
#pragma unroll
                for (int bj = 0; bj < 2; ++bj) {
                    float v[8];
#pragma unroll
                    for (int n = 0; n < 2; ++n)
#pragma unroll
                        for (int e = 0; e < 4; ++e) { const float t = fmaxf(acc[ai][bj][m][n][e], 0.f); v[4 * n + e] = t * t; }
                    u32x4 w; w.x = pk_bf16(v[0], v[1]); w.y = pk_bf16(v[2], v[3]); w.z = pk_bf16(v[4], v[5]); w.w = pk_bf16(v[6], v[7]);
                    *(u32x4*)(rp + bj * 128) = w;
                }
            }
    }
};

struct EpiRes2 {
    static constexpr bool PERM = true, AFTER_DRAIN = false;
    const float* resid; float* hout; bf16_t* hb; float* sumsq_next; const float* sumsq_in;
    DI void operator()(const pg8::f32x4 (&acc)[2][2][4][2], const pg8::Unit& u, int wr, int wc, int fr, int fq) const {
        const int row0 = u.pm * 256 + wr * 64 + fr, col0 = u.pn * 256 + wc * 32 + 8 * fq;
#pragma unroll
        for (int ai = 0; ai < 2; ++ai)
#pragma unroll
            for (int m = 0; m < 4; ++m) {
                const int row = row0 + ai * 128 + m * 16; float ss = 0.f;
                const float r2 = sumsq_in ? 1.0f / (sumsq_in[row] * (1.0f / 1024.0f) + EPS) : 1.0f;
#pragma unroll
                for (int bj = 0; bj < 2; ++bj) {
                    const size_t off = (size_t)row * 1024 + col0 + bj * 128;
                    f32x4 r0 = *(const f32x4*)(resid + off), r1 = *(const f32x4*)(resid + off + 4);
#pragma unroll
                    for (int e = 0; e < 4; ++e) { r0[e] += acc[ai][bj][m][0][e] * r2; r1[e] += acc[ai][bj][m][1][e] * r2; ss += r0[e] * r0[e] + r1[e] * r1[e]; }
                    *(f32x4*)(hout + off) = r0; *(f32x4*)(hout + off + 4) = r1;
                    u32x4 w; w.x = pk_bf16(r0[0], r0[1]); w.y = pk_bf16(r0[2], r0[3]); w.z = pk_bf16(r1[0], r1[1]); w.w = pk_bf16(r1[2], r1[3]);
                    if (hb) *(u32x4*)(hb + off) = w;
                }
                ss += __shfl_xor(ss, 16); ss += __shfl_xor(ss, 32);
                if (fq == 0) __hip_atomic_fetch_add(sumsq_next + row, ss, __ATOMIC_RELAXED, __HIP_MEMORY_SCOPE_AGENT);
                asm volatile("" ::: "memory");
            }
    }
};

DI void rope8(float (&v)[8], const float* __restrict__ rope, int s, int fq) {
    const f32x4 c0 = *(const f32x4*)(rope + s * 16), c1 = *(const f32x4*)(rope + s * 16 + 4), s0 = *(const f32x4*)(rope + s * 16 + 8), s1 = *(const f32x4*)(rope + s * 16 + 12);
    const float cs[8] = {c0[0], c0[1], c0[2], c0[3], c1[0], c1[1], c1[2], c1[3]}, sn[8] = {s0[0], s0[1], s0[2], s0[3], s1[0], s1[1], s1[2], s1[3]};
#pragma unroll
    for (int e = 0; e < 8; ++e) {
        const float other = __shfl_xor(v[e], 16);
        const float a = v[e] * cs[e], bq = other * sn[e];
        v[e] = (fq == 0) ? (a - bq) : ((fq == 1) ? (a + bq) : v[e]);
    }
}

struct EpiProj0b {
    static constexpr bool PERM = true, AFTER_DRAIN = false;
    const float* sumsq; bf16_t* P; bf16_t* vta; bf16_t* vtf; float* logf; const float* bfg; const float* rope;
    DI void operator()(const pg8::f32x4 (&acc)[2][2][4][2], const pg8::Unit& u, int wr, int wc, int fr, int fq) const {
        const int row0 = u.pm * 256 + wr * 64 + fr;
#pragma unroll
        for (int bj = 0; bj < 2; ++bj) {
            const int cb = u.pn * 256 + bj * 128;
            if (cb > 3072) continue;
            if (cb == 3072 && wc != 0) continue;
            const int col0 = cb + wc * 32 + 8 * fq;
            const int region = cb >> 9;
#pragma unroll
            for (int ai = 0; ai < 2; ++ai)
#pragma unroll
                for (int m = 0; m < 4; ++m) {
                    const int row = row0 + ai * 128 + m * 16;
                    const float rstd = rsqrtf(sumsq[row] * (1.0f / 1024.0f) + EPS);
                    const int s = row & (SEQ - 1), b = row >> 13;
                    float v[8];
#pragma unroll
                    for (int n = 0; n < 2; ++n)
#pragma unroll
                        for (int e = 0; e < 4; ++e) v[4 * n + e] = acc[ai][bj][m][n][e] * rstd;
                    if (cb == 3072) {
                        if (fq == 0) {
                            f32x4 o0, o1;
#pragma unroll
                            for (int e = 0; e < 4; ++e) {
                                const float x0 = v[e] + bfg[e], x1 = v[4 + e] + bfg[4 + e];
                                o0[e] = fminf(x0, 0.f) - __logf(1.0f + __expf(-fabsf(x0))); o1[e] = fminf(x1, 0.f) - __logf(1.0f + __expf(-fabsf(x1)));
                            }
                            *(f32x4*)(logf + (size_t)row * 8) = o0; *(f32x4*)(logf + (size_t)row * 8 + 4) = o1;
                        }
                    } else if (region == 2 || region == 5) {
                        const int c = col0 - region * 512;
                        bf16_t* vt = (region == 2 ? vta : vtf) + ((size_t)(b * 512 + c) * SEQ + s);
#pragma unroll
                        for (int e = 0; e < 8; ++e) vt[(size_t)e * SEQ] = to_bf16(v[e]);
                    } else {
                        if (region < 2 && (wc & 1) == 0) rope8(v, rope, s, fq);
                        const float qs = (region == 0 || region == 3) ? QSCALE : 1.0f;
                        u32x4 w; w.x = pk_bf16(v[0] * qs, v[1] * qs); w.y = pk_bf16(v[2] * qs, v[3] * qs); w.z = pk_bf16(v[4] * qs, v[5] * qs); w.w = pk_bf16(v[6] * qs, v[7] * qs);
                        *(u32x4*)(P + (size_t)row * P0_PITCH + col0) = w;
                    }
                    asm volatile("" ::: "memory");
                }
        }
    }
};

struct EpiProj1b {
    static constexpr bool PERM = true, AFTER_DRAIN = false;
    const float* sumsq; bf16_t* P; bf16_t* vt1; float* ikraw; float* iw; const float* rope;
    DI void operator()(const pg8::f32x4 (&acc)[2][2][4][2], const pg8::Unit& u, int wr, int wc, int fr, int fq) const {
        const int row0 = u.pm * 256 + wr * 64 + fr;
#pragma unroll
        for (int bj = 0; bj < 2; ++bj) {
            const int cb = u.pn * 256 + bj * 128;
            if (cb > 3584) continue;
            if (cb == 3584 && wc == 3) continue;
            const int col0 = cb + wc * 32 + 8 * fq;
#pragma unroll
            for (int ai = 0; ai < 2; ++ai)
#pragma unroll
                for (int m = 0; m < 4; ++m) {
                    const int row = row0 + ai * 128 + m * 16;
                    const float rstd = rsqrtf(sumsq[row] * (1.0f / 1024.0f) + EPS);
                    const int s = row & (SEQ - 1), b = row >> 13;
                    float v[8];
#pragma unroll
                    for (int n = 0; n < 2; ++n)
#pragma unroll
                        for (int e = 0; e < 4; ++e) v[4 * n + e] = acc[ai][bj][m][n][e] * rstd;
                    if (cb == 3584) {
                        if (wc < 2) {
                            float* d = ikraw + (size_t)row * 64 + wc * 32 + 8 * fq;
                            *(f32x4*)d = (f32x4){v[0], v[1], v[2], v[3]}; *(f32x4*)(d + 4) = (f32x4){v[4], v[5], v[6], v[7]};
                        } else if (fq == 0) {
                            const float sc = 0.044194173824159216f;
                            *(f32x4*)(iw + (size_t)row * 8) = (f32x4){v[0] * sc, v[1] * sc, v[2] * sc, v[3] * sc}; *(f32x4*)(iw + (size_t)row * 8 + 4) = (f32x4){v[4] * sc, v[5] * sc, v[6] * sc, v[7] * sc};
                        }
                    } else if (cb >= 2048 && cb < 3072) {
                        const int c = col0 - 2048;
                        bf16_t* vt = vt1 + ((size_t)(b * 1024 + c) * SEQ + s);
#pragma unroll
                        for (int e = 0; e < 8; ++e) vt[(size_t)e * SEQ] = to_bf16(v[e]);
                    } else {
                        if ((wc & 1) == 0) rope8(v, rope, s, fq);
                        const float qs = (cb < 1024) ? QSCALE : 1.0f;
                        u32x4 w; w.x = pk_bf16(v[0] * qs, v[1] * qs); w.y = pk_bf16(v[2] * qs, v[3] * qs); w.z = pk_bf16(v[4] * qs, v[5] * qs); w.w = pk_bf16(v[6] * qs, v[7] * qs);
                        *(u32x4*)(P + (size_t)row * P1_PITCH + col0) = w;
                    }
                    asm volatile("" ::: "memory");
                }
        }
    }
};

DI void phase_iknorm(const Params& p) {
    const int tid = threadIdx.x, lane = tid & 63, wid = tid >> 6;
    const float* ikraw = (const float*)(p.ws + WS_BITMASK);
    bf16_t* ikb = (bf16_t*)(p.ws + WS_IKB);
    const float* rope = (const float*)(p.ws + WS_ROPE);
    const float g = p.in[11][lane], bt = p.in[12][lane];
    for (int row = blockIdx.x * 8 + wid; row < T_TOK; row += gridDim.x * 8) {
        const float x = ikraw[(size_t)row * 64 + lane];
        const float mean = wave_sum(x) * (1.0f / 64.0f);
        const float d = x - mean;
        const float var = wave_sum(d * d) * (1.0f / 64.0f);
        float y = d * rsqrtf(var + EPS) * g + bt;
        const int s = row & (SEQ - 1);
        const float other = __shfl_xor(y, 8);
        const float cs = rope[s * 16 + (lane & 7)], sn = rope[s * 16 + 8 + (lane & 7)];
        if (lane < 8) y = y * cs - other * sn; else if (lane < 16) y = y * cs + other * sn;
        ikb[(size_t)row * 64 + lane] = to_bf16(y);
    }
}

DI void phase_scan(const Params& p, unsigned char* lds) {
    {
        const bf16_t* P = (const bf16_t*)(p.ws + WS_PBUF);
        unsigned* bnd = (unsigned*)(p.ws + WS_BND);
        for (int u = blockIdx.x; u < 256; u += gridDim.x) {
            const int bh = u >> 3, b = bh >> 3, h = bh & 7, chunk = u & 7;
            float qm = 0.f, km = 0.f;
#pragma unroll
            for (int j = 0; j < 2; ++j) {
                const int s = chunk * 1024 + j * 512 + (int)threadIdx.x;
                const bf16_t* row = P + (size_t)(b * SEQ + s) * P0_PITCH + h * 64;
                float qs = 0.f, ks = 0.f;
#pragma unroll
                for (int c = 0; c < 8; ++c) {
                    const u32x4 qv = *(const u32x4*)(row + 1536 + c * 8), kv = *(const u32x4*)(row + 2048 + c * 8);
#pragma unroll
                    for (int e = 0; e < 4; ++e) {
                        const float q0 = __uint_as_float(qv[e] << 16), q1 = __uint_as_float(qv[e] & 0xffff0000u);
                        const float k0 = __uint_as_float(kv[e] << 16), k1 = __uint_as_float(kv[e] & 0xffff0000u);
                        qs += q0 * q0 + q1 * q1; ks += k0 * k0 + k1 * k1;
                    }
                }
                qm = fmaxf(qm, qs); km = fmaxf(km, ks);
            }
#pragma unroll
            for (int d = 32; d >= 1; d >>= 1) { qm = fmaxf(qm, __shfl_xor(qm, d)); km = fmaxf(km, __shfl_xor(km, d)); }
            if ((threadIdx.x & 63) == 0) { atomicMax(bnd + bh * 2, __float_as_uint(qm)); atomicMax(bnd + bh * 2 + 1, __float_as_uint(km)); }
        }
    }
    const float* logf = (const float*)(p.ws + WS_LOGF);
    float* c2 = (float*)(p.ws + WS_C2);
    float* wsum = (float*)lds;
    const int tid = threadIdx.x, lane = tid & 63, wid = tid >> 6;
    for (int u = blockIdx.x; u < 32; u += gridDim.x) {
        const int b = u >> 3, h = u & 7;
        float v[16]; float tot = 0.f;
#pragma unroll
        for (int j = 0; j < 16; ++j) { v[j] = logf[((size_t)b * SEQ + tid * 16 + j) * 8 + h]; tot += v[j]; v[j] = tot; }
        float inc = tot;
#pragma unroll
        for (int d = 1; d < 64; d <<= 1) { const float o = __shfl_up(inc, d); if (lane >= d) inc += o; }
        if (lane == 63) wsum[wid] = inc;
        __syncthreads();
        float base = inc - tot;
        for (int w = 0; w < wid; ++w) base += wsum[w];
#pragma unroll
        for (int j = 0; j < 16; ++j) c2[((size_t)(b * 8 + h)) * SEQ + tid * 16 + j] = (base + v[j]) * LOG2E;
        __syncthreads();
    }
}

template <int MODE, int DRY = 0>
DI void attn_phase(const Params& p, unsigned char* lds) {
    constexpr int DVB = (MODE == 0) ? 4 : 2;
    constexpr int QU = (MODE == 0) ? 128 : 256;
    constexpr int NH = (MODE == 0) ? 4 : (MODE == 1 ? 8 : 16);
    constexpr int NQB = SEQ / QU, NBH = 4 * NH, NUNITS = NQB * NBH;
    constexpr int NJ = (MODE == 0) ? 4 : 2, NKJ = NJ / 2;
    constexpr int VT_OFF = (MODE == 0) ? 18432 : 9216;
    constexpr int CK_OFF = 17920;
    constexpr int STG = (MODE == 0) ? 35840 : 18432;
    constexpr int XCH_OFF = 3 * 35840;
    const int tid = threadIdx.x, lane = tid & 63, wid = tid >> 6, r32 = lane & 31, hh = lane >> 5;
    const int lrow = tid >> 3, lkc = tid & 7;
    const int G = gridDim.x;
    unsigned char* ws = p.ws;
    const bf16_t* P = (const bf16_t*)(ws + WS_PBUF);
    const bf16_t* VT = (const bf16_t*)(ws + WS_VT) + (MODE == 1 ? (size_t)4 * 512 * SEQ : 0);
    bf16_t* mixed = (bf16_t*)(ws + WS_MIXED);
    const float* c2 = (const float*)(ws + WS_C2);
    const u64* bitmask = (const u64*)(ws + WS_BITMASK);
    constexpr int PITCH = (MODE == 2) ? P1_PITCH : P0_PITCH;
    float lam = 0.f;
    if (MODE == 0) {
        float d1 = 0.f, d2 = 0.f;
        for (int i = 0; i < 64; ++i) { d1 += p.in[4][i] * p.in[5][i]; d2 += p.in[6][i] * p.in[7][i]; }
        lam = expf(d1) - expf(d2) + 0.2f;
    }
    for (int it = 0; it * G < NUNITS; ++it) {
        int qb, bh;
        if (MODE == 1 && G == 256) {
            const int p_ = (int)blockIdx.x, hbase = p_ & 7, bsel = (p_ >> 3) & 3, qgrp = p_ >> 5;
            qb = 8 * (3 - it) + qgrp; bh = bsel * 8 + ((hbase + 3 * it) & 7);
        } else {
            const int pos = (it & 1) ? (G - 1 - (int)blockIdx.x) : (int)blockIdx.x;
            const int u = it * G + pos;
            if (u >= NUNITS) continue;
            qb = NQB - 1 - u / NBH; bh = u % NBH;
        }
        const int b = bh / NH, h = bh % NH;
        const int q0 = qb * QU;
        const int cmap = (MODE == 0) ? (wid >> 2) : 0;
        const int qw0 = q0 + 32 * ((MODE == 0) ? (wid & 3) : wid);
        const int nt = (q0 + QU) >> 6;
        const int myq = qw0 + r32;
        int j0 = 0;
        if (MODE == 1) {
            const unsigned* bnd = (const unsigned*)(ws + WS_BND) + (b * 8 + h) * 2;
            const float Bnd = sqrtf(__uint_as_float(bnd[0]) * __uint_as_float(bnd[1])) * 1.02f + 0.5f;
            const float thr = -(2.0f * Bnd + 30.0f);
            const float* cc = c2 + (size_t)(b * 8 + h) * SEQ;
            const float cq0 = cc[q0];
            int lo = 0, hi = q0 >> 6;
            while (lo < hi) { const int mid = (lo + hi) >> 1; if (cq0 - cc[64 * mid + 63] >= thr) hi = mid; else lo = mid + 1; }
            j0 = lo;
        }
        const int ntl = nt - j0;
        const bf16_t* src[NJ]; size_t step[NJ];
        if (MODE == 0) {
            src[0] = P + (size_t)(b * SEQ + lrow) * PITCH + 512 + (h * 2) * 64 + lkc * 8; step[0] = (size_t)64 * PITCH;
            src[1] = src[0] + 64; step[1] = step[0];
            src[2] = VT + (size_t)(b * 512 + h * 128 + lrow) * SEQ + lkc * 8; step[2] = 64;
            src[3] = src[2] + (size_t)64 * SEQ; step[3] = 64;
        } else if (MODE == 1) {
            src[0] = P + (size_t)(b * SEQ + lrow) * PITCH + 2048 + h * 64 + lkc * 8; step[0] = (size_t)64 * PITCH;
            src[1] = VT + (size_t)(b * 512 + h * 64 + lrow) * SEQ + lkc * 8; step[1] = 64;
        } else {
            src[0] = P + (size_t)(b * SEQ + lrow) * PITCH + 1024 + h * 64 + lkc * 8; step[0] = (size_t)64 * PITCH;
            src[1] = VT + (size_t)(b * 1024 + h * 64 + lrow) * SEQ + lkc * 8; step[1] = 64;
        }
        const int qcol = (MODE == 0) ? (h * 2 + cmap) * 64 : (MODE == 1 ? 1536 + h * 64 : h * 64);
        bf16x8 qf[4];
#pragma unroll
        for (int ks = 0; ks < 4; ++ks) qf[ks] = *(const bf16x8*)(P + (size_t)(b * SEQ + myq) * PITCH + qcol + 16 * ks + 8 * hh);
        const float* ckp = nullptr;
        if (MODE == 1) ckp = c2 + (size_t)(b * 8 + h) * SEQ;
        const u64* mrow = nullptr; u64 wcur = 0, wnext = 0, wnext2 = 0;
        if (MODE == 2) { mrow = bitmask + (size_t)(b * SEQ + myq) * 128; wcur = mrow[0]; }
        f32x16 o[DVB];
#pragma unroll
        for (int db = 0; db < DVB; ++db)
#pragma unroll
            for (int i = 0; i < 16; ++i) o[db][i] = 0.f;
        float m = -1e30f, l = 0.f;
        constexpr bool DEEP = (MODE != 0);
        u32x4 rgE[NJ], rgO[NJ]; float ckrE = 0.f, ckrO = 0.f;
        auto gload = [&](u32x4 (&rg)[NJ], float& ckr, int t) {
#pragma unroll
            for (int j = 0; j < NJ; ++j) rg[j] = *(const u32x4*)(src[j] + (size_t)t * step[j]);
            if (MODE == 1 && tid < 64) ckr = ckp[t * 64 + tid];
        };
        auto lstore = [&](const u32x4 (&rg)[NJ], const float ckr, int stg) {
            unsigned char* sb = lds + stg * STG;
#pragma unroll
            for (int j = 0; j < NJ; ++j) {
                if (j < NKJ) *(u32x4*)(sb + j * 9216 + lrow * 144 + lkc * 16) = rg[j];
                else { unsigned char* d = sb + VT_OFF + (lrow + 64 * (j - NKJ)) * 136 + lkc * 16; u32x2 a, c; a.x = rg[j].x; a.y = rg[j].y; c.x = rg[j].z; c.y = rg[j].w; *(u32x2*)d = a; *(u32x2*)(d + 8) = c; }
            }
            if (MODE == 1 && tid < 64) *(float*)(sb + CK_OFF + tid * 4) = ckr;
        };
        const unsigned koff = cmap * 9216 + r32 * 144 + hh * 16;
        const unsigned voff = VT_OFF + r32 * 136 + hh * 8;
        auto qk = [&](f32x16 (&s)[2], float& mi, int stg) {
            const unsigned char* kb_ = lds + stg * STG + koff;
            const unsigned mb = pk_bf16((m > -1e29f) ? -m : 0.f, 0.f) & 0xffffu;
            mi = -__uint_as_float(mb << 16);
            u32x4 qxw; qxw.x = hh ? 0u : mb; qxw.y = 0u; qxw.z = 0u; qxw.w = 0u;
            u32x4 kxw; kxw.x = hh ? 0u : 0x3f80u; kxw.y = 0u; kxw.z = 0u; kxw.w = 0u;
            const bf16x8 qx = __builtin_bit_cast(bf16x8, qxw), kx = __builtin_bit_cast(bf16x8, kxw);
            f32x16 zero;
#pragma unroll
            for (int i = 0; i < 16; ++i) zero[i] = 0.f;
#pragma unroll
            for (int blk = 0; blk < 2; ++blk) {
                s[blk] = MFMA32(kx, qx, zero);
#pragma unroll
                for (int ks = 0; ks < 4; ++ks) {
                    const bf16x8 kf = *(const bf16x8*)(kb_ + blk * 4608 + ks * 32);
                    s[blk] = MFMA32(kf, qf[ks], s[blk]);
                }
            }
        };
        auto softmax_pv = [&](f32x16 (&s)[2], const float mi, int kt, int stg) {
            const int k0 = kt * 64;
            const unsigned char* sb = lds + stg * STG;
            if (DRY != 1) {
            if (MODE == 1) {
#pragma unroll
                for (int blk = 0; blk < 2; ++blk)
#pragma unroll
                    for (int g = 0; g < 4; ++g) {
                        const f32x4 c4 = *(const f32x4*)(sb + CK_OFF + (32 * blk + 8 * g + 4 * hh) * 4);
#pragma unroll
                        for (int e = 0; e < 4; ++e) s[blk][4 * g + e] -= c4[e];
                    }
            }
            if (MODE == 2) {
                const u64 wsh = wcur >> (4 * hh);
                const int wlo = (int)(unsigned)wsh, whi = (int)(unsigned)(wsh >> 32);
#pragma unroll
                for (int i = 0; i < 16; ++i) {
                    const int bit = (i & 3) + 8 * (i >> 2);
                    const unsigned m0 = (unsigned)__builtin_amdgcn_sbfe(wlo, bit, 1), m1 = (unsigned)__builtin_amdgcn_sbfe(whi, bit, 1);
                    s[0][i] = __uint_as_float((__float_as_uint(s[0][i]) & m0) | (0xff800000u & ~m0));
                    s[1][i] = __uint_as_float((__float_as_uint(s[1][i]) & m1) | (0xff800000u & ~m1));
                }
            } else if (k0 + 63 > qw0) {
#pragma unroll
                for (int blk = 0; blk < 2; ++blk)
#pragma unroll
                    for (int i = 0; i < 16; ++i) { const int key = k0 + 32 * blk + crow(i, hh); if (key > myq) s[blk][i] = -INFINITY; }
            }
            float mx = s[0][0];
#pragma unroll
            for (int i = 1; i < 16; ++i) mx = fmaxf(mx, s[0][i]);
#pragma unroll
            for (int i = 0; i < 16; ++i) mx = fmaxf(mx, s[1][i]);
            mx = xhalf_max(mx);
            const float mabs = mi + mx;
            const bool up = mabs > m + 8.0f;
            const float mn = up ? __uint_as_float(pk_bf16(mabs, 0.f) << 16) : m;
            const float shift = mn - mi;
            if (__ballot(shift != 0.f) != 0) {
                if (__ballot(up) != 0) {
                    const float alpha = __builtin_amdgcn_exp2f(m - mn);
                    l *= alpha;
#pragma unroll
                    for (int db = 0; db < DVB; ++db)
#pragma unroll
                        for (int i = 0; i < 16; ++i) o[db][i] *= alpha;
                    m = mn;
                }
#pragma unroll
                for (int blk = 0; blk < 2; ++blk)
#pragma unroll
                    for (int i = 0; i < 16; ++i) s[blk][i] -= shift;
            }
            float ls = 0.f;
#pragma unroll
            for (int blk = 0; blk < 2; ++blk)
#pragma unroll
                for (int i = 0; i < 16; ++i) { const float e = __builtin_amdgcn_exp2f(s[blk][i]); s[blk][i] = e; ls += e; }
            l += ls;
            }
#pragma unroll
            for (int blk = 0; blk < 2; ++blk)
#pragma unroll
                for (int sp = 0; sp < 2; ++sp) {
                    u32x4 pw;
                    pw.x = pk_bf16(s[blk][8 * sp + 0], s[blk][8 * sp + 1]); pw.y = pk_bf16(s[blk][8 * sp + 2], s[blk][8 * sp + 3]);
                    pw.z = pk_bf16(s[blk][8 * sp + 4], s[blk][8 * sp + 5]); pw.w = pk_bf16(s[blk][8 * sp + 6], s[blk][8 * sp + 7]);
                    const bf16x8 pf = __builtin_bit_cast(bf16x8, pw);
#pragma unroll
                    for (int db = 0; db < DVB; ++db) {
                        const unsigned char* va = sb + voff + db * 32 * 136 + (32 * blk + 16 * sp) * 2;
                        const u32x2 lo = *(const u32x2*)va, hi = *(const u32x2*)(va + 16);
                        u32x4 vw; vw.x = lo.x; vw.y = lo.y; vw.z = hi.x; vw.w = hi.y;
                        o[db] = MFMA32(__builtin_bit_cast(bf16x8, vw), pf, o[db]);
                    }
                }
        };
        auto stepf = [&](f32x16 (&s_cur)[2], const float mi_cur, f32x16 (&s_nxt)[2], float& mi_nxt, u32x4 (&rg_ld)[NJ], float& ck_ld, const u32x4 (&rg_st)[NJ], const float ck_st, int kk) {
            const int kt = j0 + kk;
            if (DEEP) { if (kk + 3 < ntl) gload(rg_ld, ck_ld, kt + 3); } else { if (kk + 2 < ntl) gload(rg_ld, ck_ld, kt + 2); }
            if (MODE == 2 && kk + 2 < ntl) wnext2 = mrow[kt + 2];
            if (kk + 1 < ntl && (kt + 1) * 64 <= qw0 + 31) qk(s_nxt, mi_nxt, (kk + 1) % 3);
            if (kt * 64 <= qw0 + 31) softmax_pv(s_cur, mi_cur, kt, kk % 3);
            if (MODE == 2) { wcur = wnext; wnext = wnext2; }
            if (kk + 2 < ntl) lstore(rg_st, ck_st, (kk + 2) % 3);
            __syncthreads();
        };
        gload(rgE, ckrE, j0); lstore(rgE, ckrE, 0);
        if (ntl > 1) { gload(rgE, ckrE, j0 + 1); lstore(rgE, ckrE, 1); }
        if (DEEP && ntl > 2) gload(rgO, ckrO, j0 + 2);
        if (MODE == 2 && ntl > 1) wnext = mrow[j0 + 1];
        __syncthreads();
        f32x16 sA[2], sB[2]; float miA = 0.f, miB = 0.f;
        if (j0 * 64 <= qw0 + 31) qk(sA, miA, 0);
        for (int kk = 0; kk < ntl; kk += 2) {
            if (DEEP) {
                stepf(sA, miA, sB, miB, rgE, ckrE, rgO, ckrO, kk);
                if (kk + 1 < ntl) stepf(sB, miB, sA, miA, rgO, ckrO, rgE, ckrE, kk + 1);
            } else {
                stepf(sA, miA, sB, miB, rgE, ckrE, rgE, ckrE, kk);
                if (kk + 1 < ntl) stepf(sB, miB, sA, miA, rgE, ckrE, rgE, ckrE, kk + 1);
            }
        }
        l = xhalf_sum(l);
        const float inv = 1.0f / l;
        const int tok = b * SEQ + myq;
        if (DRY != 0 && o[0][0] != 12345.678f) continue;
        if (MODE == 0) {
            float* xch = (float*)(lds + XCH_OFF);
            const int qs = wid & 3;
#pragma unroll
            for (int db = 0; db < DVB; ++db) {
                if (cmap == 1) {
#pragma unroll
                    for (int i = 0; i < 16; ++i) xch[(qs * 16 + i) * 64 + lane] = o[db][i] * inv;
                }
                __syncthreads();
                if (cmap == 0) {
#pragma unroll
                    for (int i = 0; i < 16; ++i) o[db][i] = o[db][i] * inv - lam * xch[(qs * 16 + i) * 64 + lane];
                }
                __syncthreads();
            }
            if (cmap == 0) {
                float ss = 0.f;
#pragma unroll
                for (int db = 0; db < DVB; ++db)
#pragma unroll
                    for (int i = 0; i < 16; ++i) ss += o[db][i] * o[db][i];
                ss = xhalf_sum(ss);
                const float rn = rsqrtf(ss * (1.0f / 128.0f) + EPS) * 0.8f;
                const float* subg = p.in[8];
#pragma unroll
                for (int db = 0; db < DVB; ++db)
#pragma unroll
                    for (int g = 0; g < 4; ++g) {
                        const int d0 = 32 * db + 8 * g + 4 * hh;
                        const f32x4 gg = *(const f32x4*)(subg + d0);
                        store4_bf16(mixed + (size_t)tok * 1024 + h * 128 + d0, o[db][4 * g] * rn * gg[0], o[db][4 * g + 1] * rn * gg[1], o[db][4 * g + 2] * rn * gg[2], o[db][4 * g + 3] * rn * gg[3]);
                    }
            }
        } else {
            const int cbase = (MODE == 1) ? 512 + h * 64 : h * 64;
#pragma unroll
            for (int db = 0; db < DVB; ++db)
#pragma unroll
                for (int g = 0; g < 4; ++g)
                    store4_bf16(mixed + (size_t)tok * 1024 + cbase + 32 * db + 8 * g + 4 * hh, o[db][4 * g] * inv, o[db][4 * g + 1] * inv, o[db][4 * g + 2] * inv, o[db][4 * g + 3] * inv);
        }
    }
}

DI unsigned sortable(float x) { if (x == 0.f) x = 0.f; const unsigned u = __float_as_uint(x); return (u & 0x80000000u) ? ~u : (u | 0x80000000u); }

DI void hist_select(const unsigned* hrow, int need, int lane, int& bsel, int& above, bool& hit) {
    const u32x4 w0 = *(const u32x4*)(hrow + 8 * lane), w1 = *(const u32x4*)(hrow + 8 * lane + 4);
    unsigned wv[8] = {w0.x, w0.y, w0.z, w0.w, w1.x, w1.y, w1.z, w1.w};
    int cnt[16]; int tot = 0;
#pragma unroll
    for (int j = 0; j < 8; ++j) { cnt[2 * j] = (int)(wv[j] & 0xffffu); cnt[2 * j + 1] = (int)(wv[j] >> 16); tot += cnt[2 * j] + cnt[2 * j + 1]; }
    int inc = tot;
#pragma unroll
    for (int d = 1; d < 64; d <<= 1) { const int o = __shfl_down(inc, d); if (lane + d < 64) inc += o; }
    const int exc = inc - tot;
    const bool pred = (inc >= need) && (exc < need);
    const u64 bal = __ballot(pred);
    int mybin = 0, myabove = exc; bool found = false; int run = exc;
#pragma unroll
    for (int j = 15; j >= 0; --j) { if (!found && run + cnt[j] >= need) { found = true; mybin = 16 * lane + j; myabove = run; } run += cnt[j]; }
    hit = (bal != 0);
    if (bal == 0) {
        const int total = __shfl(inc, 0), c0 = __shfl(cnt[0], 0);
        bsel = 0; above = total - c0;
    } else {
        const int L = __ffsll((long long)bal) - 1;
        bsel = __shfl(mybin, L); above = __shfl(myabove, L);
    }
}

template <int N> struct IC { static constexpr int value = N; };

DI void phase_index(const Params& p, unsigned char* lds) {
    constexpr int NUNITS = 4 * 256;
    constexpr int TILE_OFF = 65536, STAGE_B = 36864, INFO_OFF = 65536 + 2 * 36864;
    const int tid = threadIdx.x, lane = tid & 63, wid = tid >> 6, r32 = lane & 31, hh = lane >> 5;
    const int lrow = tid >> 3, lkc = tid & 7;
    const int G = gridDim.x;
    unsigned char* ws = p.ws;
    const bf16_t* P = (const bf16_t*)(ws + WS_PBUF);
    const bf16_t* ikb = (const bf16_t*)(ws + WS_IKB);
    const float* iw = (const float*)(ws + WS_IW);
    u64* bitmask = (u64*)(ws + WS_BITMASK);
    unsigned* hist = (unsigned*)lds;
    int* info = (int*)(lds + INFO_OFF);
    for (int it = 0; it * G < NUNITS; ++it) {
        const int pos = (it & 1) ? (G - 1 - (int)blockIdx.x) : (int)blockIdx.x;
        const int u = it * G + pos;
        if (u >= NUNITS) continue;
        const int qblk = 255 - (u >> 2), b = u & 3;
        const int t0 = qblk * 32;
        const int nt = (t0 >> 6) + 1;
        const int nst = (nt + 3) >> 2;
        bf16x8 qf[4];
        {
            const bf16_t* qp = P + (size_t)(b * SEQ + t0 + 4 * wid + (r32 >> 3)) * P1_PITCH + 3072 + (r32 & 7) * 64 + 8 * hh;
#pragma unroll
            for (int ks = 0; ks < 4; ++ks) qf[ks] = *(const bf16x8*)(qp + 16 * ks);
        }
        f32x4 wq[4];
#pragma unroll
        for (int q = 0; q < 4; ++q) wq[q] = *(const f32x4*)(iw + (size_t)(b * SEQ + t0 + 4 * wid + q) * 8 + 4 * hh);
        const bf16_t* srcp = ikb + (size_t)(b * SEQ + lrow) * 64 + lkc * 8;
        const unsigned st_off = TILE_OFF + lrow * 144 + lkc * 16;
        const unsigned rd_off = TILE_OFF + r32 * 144 + hh * 16;
        int b1v[2] = {0, 0}, tauv[2] = {0, 0};
        int rq[4] = {0, 0, 0, 0}, cntq[4] = {0, 0, 0, 0};
        const unsigned hbase0 = (unsigned)(4 * wid + 2 * hh) * 2048u;
        const int tq0 = t0 + 4 * wid + 2 * hh;
        u64 Gm[4], Em[4];
        int cntA[2] = {0, 0}; int hiv[2] = {0, 0}, sbv[2] = {8, 8}, kshv[2] = {12, 12};
        auto mma = [&](f32x16& s, unsigned off) {
#pragma unroll
            for (int i = 0; i < 16; ++i) s[i] = 0.f;
#pragma unroll
            for (int ks = 0; ks < 4; ++ks) { const bf16x8 kf = *(const bf16x8*)(lds + off + ks * 32); s = MFMA32(qf[ks], kf, s); }
        };
        auto proc = [&](auto PASSC, auto DIAGC, const f32x16& s, int k0, int kb) {
            constexpr int PASS = decltype(PASSC)::value; constexpr bool DIAG = decltype(DIAGC)::value != 0;
            f32x4 tot;
#pragma unroll
            for (int q = 0; q < 4; ++q) {
                float pr = 0.f;
#pragma unroll
                for (int e = 0; e < 4; ++e) pr += wq[q][e] * fmaxf(s[4 * q + e], 0.f);
                tot[q] = xhalf_sum(pr);
            }
            const int key = k0 + 32 * kb + r32;
#pragma unroll
            for (int qq = 0; qq < 2; ++qq) {
                const float t_lo = tot[qq], t_hi = tot[2 + qq];
                const float sc = ((lane & 32) ? t_hi : t_lo) + 0.0f;
                const unsigned ub = __float_as_uint(sc);
                const unsigned uk = ub ^ ((unsigned)((int)ub >> 31) | 0x80000000u);
                const bool valid = DIAG ? (key <= tq0 + qq) : true;
                if (PASS == 0) {
                    if (valid) { const unsigned a = (uk >> 21) & 0x7feu; atomicAdd((unsigned*)(lds + hbase0 + qq * 2048 + (a & ~3u)), 1u << ((a & 2u) << 3)); }
                } else if (PASS == 1) {
                    if (valid && (int)(uk >> 22) == b1v[qq]) { const unsigned a = (uk >> 11) & 0x7feu; atomicAdd((unsigned*)(lds + hbase0 + qq * 2048 + (a & ~3u)), 1u << ((a & 2u) << 3)); }
                } else if (PASS == 3) {
                    if (valid) {
                        const int k10 = (int)(uk >> 22), d = k10 - b1v[qq];
                        if (k10 > hiv[qq]) cntA[qq] += 1;
                        else if (d >= 0) {
                            const unsigned bin = ((unsigned)d << sbv[qq]) | ((uk >> (22 - sbv[qq])) & ((1u << sbv[qq]) - 1u));
                            const unsigned a = bin << 1;
                            atomicAdd((unsigned*)(lds + hbase0 + qq * 2048 + (a & ~3u)), 1u << ((a & 2u) << 3));
                        }
                    }
                } else {
                    const int k20 = (int)(uk >> kshv[qq]);
                    const u64 bg = __ballot(valid && k20 > tauv[qq]);
                    const u64 be = __ballot(valid && k20 == tauv[qq]);
                    Gm[qq] |= (bg & 0xffffffffull) << (32 * kb); Gm[2 + qq] |= (bg >> 32) << (32 * kb);
                    Em[qq] |= (be & 0xffffffffull) << (32 * kb); Em[2 + qq] |= (be >> 32) << (32 * kb);
                }
            }
        };
        auto finish_tile = [&](int kt) {
#pragma unroll
            for (int q = 0; q < 4; ++q) {
                u64 take = Em[q];
                const int neq = __popcll(take);
                if (cntq[q] + neq > rq[q]) {
                    int keep = rq[q] - cntq[q]; if (keep < 0) keep = 0;
                    while (__popcll(take) > keep) take &= ~(1ull << (63 - __clzll((long long)take)));
                }
                cntq[q] += neq;
                const u64 fin = Gm[q] | take;
                if (lane == q) bitmask[(size_t)(b * SEQ + t0 + 4 * wid + q) * 128 + kt] = fin;
            }
        };
        auto run_pass = [&](auto PASSC, const bool samp) {
            constexpr int PASS = decltype(PASSC)::value;
            if (PASS == 3) { cntA[0] = 0; cntA[1] = 0; }
            if (PASS != 2) {
#pragma unroll
                for (int j = 0; j < 8; ++j) *(u32x4*)(lds + wid * 8192 + j * 1024 + lane * 16) = (u32x4){0u, 0u, 0u, 0u};
            }
            u32x4 rg[4];
#pragma unroll
            for (int j = 0; j < 4; ++j) rg[j] = *(const u32x4*)(srcp + (size_t)(64 * j) * 64);
            __syncthreads();
#pragma unroll
            for (int j = 0; j < 4; ++j) *(u32x4*)(lds + st_off + j * 9216) = rg[j];
            __syncthreads();
            for (int st = 0; st < nst; ++st) {
                const unsigned bufo = (st & 1) * STAGE_B;
                if (st + 1 < nst) {
#pragma unroll
                    for (int j = 0; j < 4; ++j) rg[j] = *(const u32x4*)(srcp + (size_t)((st + 1) * 256 + 64 * j) * 64);
                }
                const int nsub = samp ? 1 : ((nt - 4 * st) < 4 ? (nt - 4 * st) : 4);
                f32x16 sA, sB;
                mma(sA, rd_off + bufo);
                for (int sub = 0; sub < nsub; ++sub) {
                    const int kt = 4 * st + sub, k0 = kt * 64;
                    const unsigned toff = rd_off + bufo + sub * 9216;
                    if (PASS == 2) {
#pragma unroll
                        for (int q = 0; q < 4; ++q) { Gm[q] = 0; Em[q] = 0; }
                    }
                    mma(sB, toff + 4608);
                    if (kt == nt - 1) proc(PASSC, IC<1>{}, sA, k0, 0); else proc(PASSC, IC<0>{}, sA, k0, 0);
                    if (sub + 1 < nsub) mma(sA, toff + 9216);
                    if (kt == nt - 1) proc(PASSC, IC<1>{}, sB, k0, 1); else proc(PASSC, IC<0>{}, sB, k0, 1);
                    if (PASS == 2) finish_tile(kt);
                }
                if (st + 1 < nst) {
#pragma unroll
                    for (int j = 0; j < 4; ++j) *(u32x4*)(lds + st_off + (STAGE_B - bufo) + j * 9216) = rg[j];
                }
                __syncthreads();
            }
            if (PASS != 2) {
                int ca0 = cntA[0], ca1 = cntA[1];
                if (PASS == 3) {
#pragma unroll
                    for (int d = 1; d < 32; d <<= 1) { ca0 += __shfl_xor(ca0, d); ca1 += __shfl_xor(ca1, d); }
                }
#pragma unroll
                for (int q = 0; q < 4; ++q) {
                    const int ql = 4 * wid + q;
                    int need = 256;
                    if (PASS == 0) need = samp ? 64 : 256;
                    else if (PASS == 1) need = info[ql * 4 + 1];
                    else need = 256 - __shfl((q & 1) ? ca1 : ca0, 32 * (q >> 1));
                    int bsel, above; bool hit;
                    if (PASS == 0 && samp) {
                        int bhi, blo, ab2; bool h2;
                        hist_select(hist + ql * 512, 32, lane, bhi, above, hit);
                        hist_select(hist + ql * 512, 128, lane, blo, ab2, h2);
                        if (!h2) blo = 0;
                        const int nb = bhi - blo + 1;
                        int sb = 8; while (sb > 0 && (nb << sb) > 1024) --sb;
                        if (lane == 0) { info[ql * 4 + 0] = blo; info[ql * 4 + 1] = bhi; info[160 + ql] = sb; if ((nb << sb) > 1024) info[128] = 1; }
                    } else {
                    hist_select(hist + ql * 512, need > 0 ? need : 1, lane, bsel, above, hit);
                    if (lane == 0) {
                        if (PASS == 0) { info[ql * 4 + 0] = bsel; info[ql * 4 + 1] = need - above; }
                        else if (PASS == 1) { info[ql * 4 + 2] = (info[ql * 4 + 0] << 10) | bsel; info[ql * 4 + 3] = need - above; info[160 + ql] = 10; }
                        else {
                            if (need <= 0 || !hit) info[128] = 1;
                            const int sb = info[160 + ql];
                            info[ql * 4 + 2] = ((info[ql * 4 + 0] + (bsel >> sb)) << sb) | (bsel & ((1 << sb) - 1)); info[ql * 4 + 3] = need - above;
                        }
                    }
                    }
                }
                __syncthreads();
#pragma unroll
                for (int qq = 0; qq < 2; ++qq) { const int ql = 4 * wid + 2 * hh + qq; b1v[qq] = info[ql * 4 + 0]; hiv[qq] = info[ql * 4 + 1]; tauv[qq] = info[ql * 4 + 2]; sbv[qq] = info[160 + ql]; kshv[qq] = 22 - sbv[qq]; }
#pragma unroll
                for (int q = 0; q < 4; ++q) { rq[q] = info[(4 * wid + q) * 4 + 3]; cntq[q] = 0; }
            }
        };
        bool have = false;
        if (nt >= 16) {
            if (tid == 0) info[128] = 0;
            run_pass(IC<0>{}, true);
            run_pass(IC<3>{}, false);
            if (info[128] == 0) have = true;
        }
        if (!have) { run_pass(IC<0>{}, false); run_pass(IC<1>{}, false); }
        run_pass(IC<2>{}, false);
        __syncthreads();
    }
}

DI void phase_final(const Params& p) {
    const int tid = threadIdx.x, lane = tid & 63, wid = tid >> 6;
    const float* sumsq = (const float*)(p.ws + WS_SUMSQ) + 4 * T_TOK;
    const float* g = p.in[17];
    float* out = p.out;
    f32x4 gg[4];
#pragma unroll
    for (int j = 0; j < 4; ++j) gg[j] = *(const f32x4*)(g + 4 * lane + 256 * j);
    for (int r0 = (blockIdx.x * 8 + wid) * 4; r0 < T_TOK; r0 += gridDim.x * 8 * 4) {
        f32x4 xv[4][4];
#pragma unroll
        for (int rr = 0; rr < 4; ++rr)
#pragma unroll
            for (int j = 0; j < 4; ++j) xv[rr][j] = *(const f32x4*)(out + (size_t)(r0 + rr) * 1024 + 4 * lane + 256 * j);
#pragma unroll
        for (int rr = 0; rr < 4; ++rr) {
            const float rstd = rsqrtf(sumsq[r0 + rr] * (1.0f / 1024.0f) + EPS);
#pragma unroll
            for (int j = 0; j < 4; ++j) {
                f32x4 v = xv[rr][j];
#pragma unroll
                for (int e = 0; e < 4; ++e) v[e] = v[e] * rstd * gg[j][e];
                *(f32x4*)(out + (size_t)(r0 + rr) * 1024 + 4 * lane + 256 * j) = v;
            }
        }
    }
}

DI void gbar(unsigned* ctr, unsigned& gen, unsigned G) {
    asm volatile("s_waitcnt vmcnt(0)" ::: "memory");
    __syncthreads();
    gen += 1;
    if (threadIdx.x == 0) {
        __builtin_amdgcn_fence(__ATOMIC_RELEASE, "agent");
        asm volatile("s_waitcnt vmcnt(0)" ::: "memory");
        __hip_atomic_fetch_add(ctr, 1u, __ATOMIC_RELAXED, __HIP_MEMORY_SCOPE_AGENT);
        while (__hip_atomic_load(ctr, __ATOMIC_RELAXED, __HIP_MEMORY_SCOPE_AGENT) < gen * G) __builtin_amdgcn_s_sleep(5);
        __builtin_amdgcn_fence(__ATOMIC_ACQUIRE, "agent");
        asm volatile("s_waitcnt vmcnt(0)" ::: "memory");
    }
    __syncthreads();
}

__global__ void __launch_bounds__(NTHREADS) fwd_megakernel(Params p) {
    extern __shared__ __attribute__((aligned(16))) unsigned char lds[];
    cg::grid_group grid = cg::this_grid();
    unsigned char* ws = p.ws;
    float* sumsq = (float*)(ws + WS_SUMSQ);
    bf16_t* hb = (bf16_t*)(ws + WS_HB);
    bf16_t* pbuf = (bf16_t*)(ws + WS_PBUF);
    bf16_t* vt = (bf16_t*)(ws + WS_VT);
    bf16_t* mixed = (bf16_t*)(ws + WS_MIXED);
    bf16_t* U = (bf16_t*)(ws + WS_PBUF);
    const float* rope = (const float*)(ws + WS_ROPE);
#define PH(k) if (p.ph_lo <= (k) && (k) < p.ph_hi)
    unsigned bgen = 0; unsigned* bctr = (unsigned*)(ws + WS_BAR);
#define SYNC(k) if (p.ph_lo <= (k) && (k) + 1 < p.ph_hi) { if ((k) == 0) grid.sync(); else gbar(bctr, bgen, gridDim.x); }
#define GEMM(EPI, e, A_, W_, N_, K_) { pg8::Gemm g{A_, W_, T_TOK, N_, K_}; pg8::StaticOrder S; S.init(T_TOK, N_, (int)gridDim.x, (int)blockIdx.x); \
        pg8::gemm_phase<EPI, pg8::StaticOrder, true, true>(l3, g, S, e); }
    PG8_LAS unsigned char* l3 = (PG8_LAS unsigned char*)lds;
    PH(0) phase_prep(p, lds);
    if (REP_PH == 0) PH(0) phase_prep(p, lds);
    SYNC(0)
    PH(1) { EpiProj0b e{sumsq, pbuf, vt, vt + (size_t)4 * 512 * SEQ, (float*)(ws + WS_LOGF), p.in[3], rope}; GEMM(EpiProj0b, e, hb, (const bf16_t*)(ws + WS_WT_IN0), 3072, 1024) }
    if (REP_PH == 1) PH(1) { EpiProj0b e{sumsq, pbuf, vt, vt + (size_t)4 * 512 * SEQ, (float*)(ws + WS_LOGF), p.in[3], rope}; GEMM(EpiProj0b, e, hb, (const bf16_t*)(ws + WS_WT_IN0), 3072, 1024) }
    SYNC(1)
    PH(2) phase_scan(p, lds);
    if (REP_PH == 2) PH(2) phase_scan(p, lds);
    SYNC(2)
    PH(3) { attn_phase<0>(p, lds); attn_phase<1>(p, lds); }
    if (REP_PH == 3) PH(3) { attn_phase<0>(p, lds); attn_phase<1>(p, lds); }
    SYNC(3)
    PH(4) { EpiRes2 e{p.in[0], p.out, hb, sumsq + T_TOK, nullptr}; GEMM(EpiRes2, e, mixed, (const bf16_t*)(ws + WS_WT_OUT0), 1024, 1024) }
    SYNC(4)
    PH(5) { EpiUp2 e{sumsq + T_TOK, U}; GEMM(EpiUp2, e, hb, (const bf16_t*)(ws + WS_WT_UP0), 4096, 1024) }
    if (REP_PH == 5) PH(5) { EpiUp2 e{sumsq + T_TOK, U}; GEMM(EpiUp2, e, hb, (const bf16_t*)(ws + WS_WT_UP0), 4096, 1024) }
    SYNC(5)
    PH(6) { EpiRes2 e{p.out, p.out, hb, sumsq + 2 * T_TOK, sumsq + T_TOK}; GEMM(EpiRes2, e, U, (const bf16_t*)(ws + WS_WT_DN0), 1024, 4096) }
    SYNC(6)
    PH(7) { EpiProj1b e{sumsq + 2 * T_TOK, pbuf, vt, (float*)(ws + WS_BITMASK), (float*)(ws + WS_IW), rope}; GEMM(EpiProj1b, e, hb, (const bf16_t*)(ws + WS_WT_IN1), 3840, 1024) }
    if (REP_PH == 7) PH(7) { EpiProj1b e{sumsq + 2 * T_TOK, pbuf, vt, (float*)(ws + WS_BITMASK), (float*)(ws + WS_IW), rope}; GEMM(EpiProj1b, e, hb, (const bf16_t*)(ws + WS_WT_IN1), 3840, 1024) }
    SYNC(7)
    PH(8) phase_iknorm(p);
    if (REP_PH == 200) { for (int i_ = 0; i_ < 10; ++i_) grid.sync(); }
    SYNC(8)
    PH(9) phase_index(p, lds);
    if (REP_PH == 9) PH(9) phase_index(p, lds);
    SYNC(9)
    if (REP_PH == 110) PH(10) attn_phase<2, 1>(p, lds);
    PH(10) attn_phase<2>(p, lds);
    if (REP_PH == 10) PH(10) attn_phase<2>(p, lds);
    SYNC(10)
    PH(11) { EpiRes2 e{p.out, p.out, hb, sumsq + 3 * T_TOK, nullptr}; GEMM(EpiRes2, e, mixed, (const bf16_t*)(ws + WS_WT_OUT1), 1024, 1024) }
    SYNC(11)
    PH(12) { EpiUp2 e{sumsq + 3 * T_TOK, U}; GEMM(EpiUp2, e, hb, (const bf16_t*)(ws + WS_WT_UP1), 4096, 1024) }
    SYNC(12)
    PH(13) { EpiRes2 e{p.out, p.out, nullptr, sumsq + 4 * T_TOK, sumsq + 3 * T_TOK}; GEMM(EpiRes2, e, U, (const bf16_t*)(ws + WS_WT_DN1), 1024, 4096) }
    SYNC(13)
    PH(14) phase_final(p);
}

extern "C" void kernel_launch(void* const* d_in, const int* in_sizes, int n_in, void* d_out, int out_size, void* d_ws, size_t ws_size, hipStream_t stream) {
    static int grid_blocks = 0;
    if (grid_blocks == 0) {
        if (n_in != 18 || ws_size < WS_END) { fprintf(stderr, "kernel_launch: unexpected n_in %d / ws_size %zu (need %zu)\n", n_in, ws_size, (size_t)WS_END); grid_blocks = -1; return; }
        int dev = 0, cus = 0, per_cu = 0;
        hipGetDevice(&dev);
        hipDeviceGetAttribute(&cus, hipDeviceAttributeMultiprocessorCount, dev);
        hipFuncSetAttribute((const void*)fwd_megakernel, hipFuncAttributeMaxDynamicSharedMemorySize, LDS_BYTES);
        hipOccupancyMaxActiveBlocksPerMultiprocessor(&per_cu, (const void*)fwd_megakernel, NTHREADS, LDS_BYTES);
        if (per_cu < 1) { fprintf(stderr, "kernel_launch: occupancy query says %d blocks/CU\n", per_cu); per_cu = 1; }
        (void)hipGetLastError();
        grid_blocks = cus;
    }
    if (grid_blocks < 0) return;
    Params p{};
    for (int i = 0; i < 18; ++i) p.in[i] = (const float*)d_in[i];
    p.out = (float*)d_out; p.ws = (unsigned char*)d_ws;
    for (int i = 0; i < 8; ++i) p.inv_freq[i] = (float)pow(500000.0, -(2.0 * i) / 16.0);
    p.ph_lo = 0; p.ph_hi = 15;
    void* args[] = {&p};
    hipError_t e = hipLaunchCooperativeKernel((const void*)fwd_megakernel, dim3(grid_blocks), dim3(NTHREADS), args, LDS_BYTES, stream);
    if (e != hipSuccess) fprintf(stderr, "cooperative launch failed: %s (grid %d)\n", hipGetErrorString(e), grid_blocks);
}
```

```cpp
#include <hip/hip_runtime.h>
#include <hip/hip_cooperative_groups.h>
#include <cstdint>
#include <cstdio>
#include <cmath>
namespace cg = cooperative_groups;

typedef unsigned short bf16_t;
typedef short bf16x8 __attribute__((ext_vector_type(8)));
typedef short s16x4 __attribute__((ext_vector_type(4)));
typedef float f32x16 __attribute__((ext_vector_type(16)));
typedef float f32x4 __attribute__((ext_vector_type(4)));
typedef float f32x2 __attribute__((ext_vector_type(2)));
typedef unsigned u32x4 __attribute__((ext_vector_type(4)));
typedef unsigned u32x2 __attribute__((ext_vector_type(2)));
typedef __bf16 bf2_t __attribute__((ext_vector_type(2)));
typedef unsigned long long u64;

#define DI __device__ __forceinline__
#define MFMA32(a, b, c) __builtin_amdgcn_mfma_f32_32x32x16_bf16((a), (b), (c), 0, 0, 0)

constexpr int T_TOK = 32768, SEQ = 8192, DM = 1024, NTHREADS = 512;
constexpr float EPS = 1e-6f;
constexpr float QSCALE = 0.125f * 1.4426950408889634f;
constexpr float LOG2E = 1.4426950408889634f;
constexpr int P0_PITCH = 3072, P1_PITCH = 3584;

constexpr size_t WS_WT_IN0 = 0;
constexpr size_t WS_WT_OUT0 = WS_WT_IN0 + (size_t)3328 * 1024 * 2;
constexpr size_t WS_WT_IN1 = WS_WT_OUT0 + (size_t)1024 * 1024 * 2;
constexpr size_t WS_WT_OUT1 = WS_WT_IN1 + (size_t)3840 * 1024 * 2;
constexpr size_t WS_WT_UP0 = WS_WT_OUT1 + (size_t)1024 * 1024 * 2;
constexpr size_t WS_WT_UP1 = WS_WT_UP0 + (size_t)4096 * 1024 * 2;
constexpr size_t WS_WT_DN0 = WS_WT_UP1 + (size_t)4096 * 1024 * 2;
constexpr size_t WS_WT_DN1 = WS_WT_DN0 + (size_t)4096 * 1024 * 2;
constexpr size_t WS_HB = WS_WT_DN1 + (size_t)4096 * 1024 * 2;
constexpr size_t WS_PBUF = WS_HB + (size_t)T_TOK * 1024 * 2;
constexpr size_t WS_VT = WS_PBUF + (size_t)T_TOK * 3584 * 2;
constexpr size_t WS_MIXED = WS_VT + (size_t)T_TOK * 1024 * 2;
constexpr size_t WS_BITMASK = WS_MIXED + (size_t)T_TOK * 1024 * 2;
constexpr size_t WS_IKB = WS_BITMASK + (size_t)T_TOK * 128 * 8;
constexpr size_t WS_IW = WS_IKB + (size_t)T_TOK * 64 * 2;
constexpr size_t WS_LOGF = WS_IW + (size_t)T_TOK * 8 * 4;
constexpr size_t WS_C2 = WS_LOGF + (size_t)T_TOK * 8 * 4;
constexpr size_t WS_SUMSQ = WS_C2 + (size_t)T_TOK * 8 * 4;
constexpr size_t WS_ROPE = WS_SUMSQ + (size_t)5 * T_TOK * 4;
constexpr size_t WS_BND = WS_ROPE + (size_t)SEQ * 16 * 4;
constexpr size_t WS_BAR = WS_BND + 256;
constexpr size_t WS_END = WS_BAR + 256;
static_assert(WS_END <= (size_t)536870912, "workspace too large");
static_assert((size_t)T_TOK * 4096 * 2 <= WS_MIXED - WS_PBUF, "U overlay too large");

constexpr int LDS_BYTES = 140288;
constexpr int REP_PH = -1;

struct Params {
    const float* in[18];
    float* out;
    unsigned char* ws;
    float inv_freq[8];
    int ph_lo, ph_hi;
};

DI unsigned pk_bf16(float a, float b) { f32x2 v = {a, b}; bf2_t r = __builtin_convertvector(v, bf2_t); return __builtin_bit_cast(unsigned, r); }
DI bf16_t to_bf16(float a) { return (bf16_t)(pk_bf16(a, 0.f) & 0xffffu); }
DI void store4_bf16(bf16_t* p, float a, float b, float c, float d) { u32x2 w; w.x = pk_bf16(a, b); w.y = pk_bf16(c, d); *(u32x2*)p = w; }
DI int crow(int i, int hh) { return (i & 3) + 8 * (i >> 2) + 4 * hh; }
DI float xhalf_sum(float v) { const auto r = __builtin_amdgcn_permlane32_swap(__float_as_uint(v), __float_as_uint(v), false, false); return __uint_as_float(r[0]) + __uint_as_float(r[1]); }
DI float xhalf_max(float v) { const auto r = __builtin_amdgcn_permlane32_swap(__float_as_uint(v), __float_as_uint(v), false, false); return fmaxf(__uint_as_float(r[0]), __uint_as_float(r[1])); }
DI float wave_sum(float v) {
#pragma unroll
    for (int d = 32; d >= 1; d >>= 1) v += __shfl_xor(v, d);
    return v;
}

struct TJob { const float* W; int K, N; const float* gain; bf16_t* dst; int k0, n0; };

DI TJob tjob_decode(const Params& p, int t) {
    unsigned char* ws = p.ws;
    TJob j; int Npad; int tt = t;
    if (tt < 384) { j.W = p.in[2]; j.K = 1024; j.N = 3080; Npad = 3072; j.gain = p.in[1]; j.dst = (bf16_t*)(ws + WS_WT_IN0); }
    else if ((tt -= 384) < 128) { j.W = p.in[9]; j.K = 1024; j.N = 1024; Npad = 1024; j.gain = nullptr; j.dst = (bf16_t*)(ws + WS_WT_OUT0); }
    else if ((tt -= 128) < 480) { j.W = p.in[10]; j.K = 1024; j.N = 3656; Npad = 3840; j.gain = p.in[1] + 1024; j.dst = (bf16_t*)(ws + WS_WT_IN1); }
    else if ((tt -= 480) < 128) { j.W = p.in[13]; j.K = 1024; j.N = 1024; Npad = 1024; j.gain = nullptr; j.dst = (bf16_t*)(ws + WS_WT_OUT1); }
    else if ((tt -= 128) < 512) { j.W = p.in[15]; j.K = 1024; j.N = 4096; Npad = 4096; j.gain = p.in[14]; j.dst = (bf16_t*)(ws + WS_WT_UP0); }
    else if ((tt -= 512) < 512) { j.W = p.in[15] + (size_t)1024 * 4096; j.K = 1024; j.N = 4096; Npad = 4096; j.gain = p.in[14] + 1024; j.dst = (bf16_t*)(ws + WS_WT_UP1); }
    else if ((tt -= 512) < 512) { j.W = p.in[16]; j.K = 4096; j.N = 1024; Npad = 1024; j.gain = nullptr; j.dst = (bf16_t*)(ws + WS_WT_DN0); }
    else { tt -= 512; j.W = p.in[16] + (size_t)4096 * 1024; j.K = 4096; j.N = 1024; Npad = 1024; j.gain = nullptr; j.dst = (bf16_t*)(ws + WS_WT_DN1); }
    const int ntn = Npad >> 7;
    j.k0 = (tt / ntn) * 64; j.n0 = (tt % ntn) * 128;
    return j;
}

DI void tjob_load(const TJob& j, float (&v)[16]) {
    const int tid = threadIdx.x;
#pragma unroll
    for (int i = 0; i < 16; ++i) {
        const int idx = tid + 512 * i, kk = idx >> 7, nn = idx & 127;
        v[i] = (j.n0 + nn < j.N) ? j.W[(size_t)(j.k0 + kk) * j.N + j.n0 + nn] : 0.f;
    }
    if (j.gain) {
#pragma unroll
        for (int i = 0; i < 16; ++i) v[i] *= j.gain[j.k0 + ((tid + 512 * i) >> 7)];
    }
}

DI void phase_prep(const Params& p, unsigned char* lds) {
    float* ldsf = (float*)lds;
    unsigned char* ws = p.ws;
    {
        const int tid = threadIdx.x;
        int t = blockIdx.x;
        float v[16];
        TJob cur{};
        if (t < 3168) { cur = tjob_decode(p, t); tjob_load(cur, v); }
        while (t < 3168) {
#pragma unroll
            for (int i = 0; i < 16; ++i) { const int idx = tid + 512 * i, kk = idx >> 7, nn = idx & 127; ldsf[nn * 65 + kk] = v[i]; }
            __syncthreads();
            const int tn = t + (int)gridDim.x;
            TJob nxt = cur;
            if (tn < 3168) { nxt = tjob_decode(p, tn); tjob_load(nxt, v); }
#pragma unroll
            for (int i = 0; i < 8; ++i) {
                const int idx = tid + 512 * i, nn = idx >> 5, kp = (idx & 31) * 2;
                *(unsigned*)(cur.dst + (size_t)(cur.n0 + nn) * cur.K + cur.k0 + kp) = pk_bf16(ldsf[nn * 65 + kp], ldsf[nn * 65 + kp + 1]);
            }
            __syncthreads();
            cur = nxt; t = tn;
        }
    }
    const int tid = threadIdx.x, lane = tid & 63, wid = tid >> 6;
    const float* x = p.in[0];
    bf16_t* hb = (bf16_t*)(ws + WS_HB);
    float* sumsq = (float*)(ws + WS_SUMSQ);
    for (int r0 = (blockIdx.x * 8 + wid) * 4; r0 < T_TOK; r0 += gridDim.x * 8 * 4) {
        f32x4 xv[4][4];
#pragma unroll
        for (int rr = 0; rr < 4; ++rr)
#pragma unroll
            for (int j = 0; j < 4; ++j) xv[rr][j] = *(const f32x4*)(x + (size_t)(r0 + rr) * 1024 + 4 * lane + 256 * j);
        float ssr[4];
#pragma unroll
        for (int rr = 0; rr < 4; ++rr) {
            const int row = r0 + rr; float ss = 0.f;
#pragma unroll
            for (int j = 0; j < 4; ++j) {
                const f32x4 v = xv[rr][j];
                ss += v[0] * v[0] + v[1] * v[1] + v[2] * v[2] + v[3] * v[3];
                store4_bf16(hb + (size_t)row * 1024 + 4 * lane + 256 * j, v[0], v[1], v[2], v[3]);
            }
            ss = wave_sum(ss); ssr[rr] = ss;
            if (lane == 0) { sumsq[row] = ss; sumsq[T_TOK + row] = 0.f; sumsq[2 * T_TOK + row] = 0.f; sumsq[3 * T_TOK + row] = 0.f; sumsq[4 * T_TOK + row] = 0.f; }
        }
        float a[32];
#pragma unroll
        for (int i = 0; i < 32; ++i) a[i] = 0.f;
        const float* Wl = p.in[2] + 3072; const float* gmix = p.in[1];
#pragma unroll
        for (int j = 0; j < 4; ++j) {
            const f32x4 g4 = *(const f32x4*)(gmix + 4 * lane + 256 * j);
#pragma unroll
            for (int e = 0; e < 4; ++e) {
                const size_t k = (size_t)(4 * lane + 256 * j + e);
                const f32x4 w0 = *(const f32x4*)(Wl + k * 3080), w1 = *(const f32x4*)(Wl + k * 3080 + 4);
#pragma unroll
                for (int rr = 0; rr < 4; ++rr) {
                    const float xk = xv[rr][j][e] * g4[e];
#pragma unroll
                    for (int c = 0; c < 4; ++c) { a[rr * 8 + c] += xk * w0[c]; a[rr * 8 + 4 + c] += xk * w1[c]; }
                }
            }
        }
        float b16[16], b8[8], b4[4], b2[2];
        { const bool bt = (lane & 32) != 0;
#pragma unroll
          for (int i = 0; i < 16; ++i) { const float snd = bt ? a[i] : a[i + 16], kp = bt ? a[i + 16] : a[i]; b16[i] = kp + __shfl_xor(snd, 32); } }
        { const bool bt = (lane & 16) != 0;
#pragma unroll
          for (int i = 0; i < 8; ++i) { const float snd = bt ? b16[i] : b16[i + 8], kp = bt ? b16[i + 8] : b16[i]; b8[i] = kp + __shfl_xor(snd, 16); } }
        { const bool bt = (lane & 8) != 0;
#pragma unroll
          for (int i = 0; i < 4; ++i) { const float snd = bt ? b8[i] : b8[i + 4], kp = bt ? b8[i + 4] : b8[i]; b4[i] = kp + __shfl_xor(snd, 8); } }
        { const bool bt = (lane & 4) != 0;
#pragma unroll
          for (int i = 0; i < 2; ++i) { const float snd = bt ? b4[i] : b4[i + 2], kp = bt ? b4[i + 2] : b4[i]; b2[i] = kp + __shfl_xor(snd, 4); } }
        float tot;
        { const bool bt = (lane & 2) != 0; const float snd = bt ? b2[0] : b2[1], kp = bt ? b2[1] : b2[0]; tot = kp + __shfl_xor(snd, 2); }
        tot += __shfl_xor(tot, 1);
        {
            const int rr = lane >> 4, c = (lane >> 1) & 7;
            const float ssm = (rr == 0) ? ssr[0] : ((rr == 1) ? ssr[1] : ((rr == 2) ? ssr[2] : ssr[3]));
            const float v = tot * rsqrtf(ssm * (1.0f / 1024.0f) + EPS) + p.in[3][c];
            if ((lane & 1) == 0) ((float*)(ws + WS_LOGF))[(size_t)(r0 + rr) * 8 + c] = fminf(v, 0.f) - __logf(1.0f + __expf(-fabsf(v)));
        }
    }
    if (blockIdx.x == 0 && threadIdx.x < 64) { ((unsigned*)(ws + WS_BND))[threadIdx.x] = 0u; ((unsigned*)(ws + WS_BAR))[threadIdx.x] = 0u; }
    float* rope = (float*)(ws + WS_ROPE);
    for (int e = blockIdx.x * NTHREADS + tid; e < SEQ * 8; e += gridDim.x * NTHREADS) {
        const int s = e >> 3, i = e & 7;
        const float ang = (float)s * p.inv_freq[i];
        const double a = (double)ang; const double k = rint(a * 0.15915494309189535); const double r = a - k * 6.283185307179586;
        const float rf = (float)r;
        rope[s * 16 + i] = __cosf(rf); rope[s * 16 + 8 + i] = __sinf(rf);
    }
}

namespace pg8 {
#define PG8_LAS __attribute__((address_space(3)))
typedef unsigned short bf16_t;
typedef short bf16x8 __attribute__((ext_vector_type(8)));
typedef float f32x4 __attribute__((ext_vector_type(4)));
typedef unsigned u32x4 __attribute__((ext_vector_type(4)));
constexpr int BM = 256, BK = 64, HALF = 128, HTB = HALF * BK * 2  , STAGE_BYTES = 8 * HTB, NXCD = 8, WGM = 8;

__host__ __device__ __forceinline__ int lds_byte(int r, int c) { const int st = (r >> 4) * 2 + (c >> 5), rr = r & 15, cc = c & 31, ob = rr * 64 + cc * 2; return st * 1024 + (ob ^ (((ob >> 9) & 1) << 5)); }
__host__ __device__ __forceinline__ void stage_rc(int b, int& R, int& C) { const int st = b / 1024, sb = b % 1024, swz = sb ^ (((sb >> 9) & 1) << 5); R = (st >> 1) * 16 + swz / 64; C = (st & 1) * 32 + (swz % 64) / 2; }
__host__ __device__ __forceinline__ int perm32(int rho) { const int n = rho >> 4, i = rho & 15; return 8 * (i >> 2) + 4 * n + (i & 3); }

struct Unit { int pm, pn; };
struct Gemm { const bf16_t* A; const bf16_t* Bt; int M, N, K; };

struct StaticOrder {
    int nM, nN, nwg, G, c;
    __host__ __device__ void init(int M, int N, int G_, int c_) { nM = M / BM; nN = N / BM; nwg = nM * nN; G = G_; c = c_; }
    __host__ __device__ bool next(int i, Unit& u) const {
        const long L = (long)i * G + c; if (L >= nwg) return false;
        int wgid = (int)L; { const int q = nwg / NXCD, r = nwg % NXCD, xcd = wgid % NXCD, off = wgid / NXCD; wgid = (xcd < r ? xcd * (q + 1) : r * (q + 1) + (xcd - r) * q) + off; }
        const int nig = WGM * nN, gid = wgid / nig, fm = gid * WGM, gsz = (nM - fm) < WGM ? (nM - fm) : WGM;
        u.pm = fm + ((wgid % nig) % gsz); u.pn = (wgid % nig) / gsz; return true;
    }
    __device__ __forceinline__ void a_ready(const Unit&) const {}
    __device__ __forceinline__ void done(const Unit&) const {}
};
__device__ __forceinline__ unsigned cvt_pk_bf16(float lo, float hi) { unsigned r; asm volatile("v_cvt_pk_bf16_f32 %0, %1, %2" : "=v"(r) : "v"(lo), "v"(hi)); return r; }
typedef float f32x2 __attribute__((ext_vector_type(2)));
template <class Epi, class Sched, bool ALIGN_EPI = false, bool SP2 = false>
__device__ __forceinline__ void gemm_phase(PG8_LAS unsigned char* lds, const Gemm g, const Sched& S, const Epi& E) {
    const int tid = threadIdx.x, wid = __builtin_amdgcn_readfirstlane(tid >> 6), lane = tid & 63, wr = wid >> 2, wc = wid & 3, fr = lane & 15, fq = lane >> 4;
    const int K = g.K, nt = K / BK;
    unsigned voffA[2], voffB[2];
#pragma unroll
    for (int i = 0; i < 2; ++i) { int R, C; stage_rc(tid * 16 + i * 8192, R, C); const int Rb = Epi::PERM ? ((R & ~31) + perm32(R & 31)) : R;
        voffA[i] = (unsigned)(R * K + C) * 2u; voffB[i] = (unsigned)(Rb * K + C) * 2u; }
    const size_t kstep = (size_t)(BK * 2);
    const size_t hstep = (size_t)HALF * K * 2;
    const size_t tstep = 2 * hstep;
    const unsigned ldsw = (unsigned)wid * 1024u;
    const int aoff = lds_byte(wr * 64 + fr, fq * 8), boff = lds_byte(wc * 32 + fr, fq * 8);
#define PG8_SA(b, h) (((b) * 2 + (h)) * HTB)
#define PG8_SB(b, h) ((4 + (b) * 2 + (h)) * HTB)
#define PG8_STAGE(bufoff, gbase, voff) do { _Pragma("unroll") for (int _i = 0; _i < 2; ++_i) \
        __builtin_amdgcn_global_load_lds((const unsigned*)((const char*)(gbase) + (voff)[_i]), (PG8_LAS unsigned*)(lds + (bufoff) + ldsw + _i * 8192), 16, 0, 0); } while (0)
#define PG8_LDA(dst, b, h) do { _Pragma("unroll") for (int m = 0; m < 4; ++m) _Pragma("unroll") for (int k = 0; k < 2; ++k) dst[m][k] = *(const PG8_LAS bf16x8*)(lds + PG8_SA(b, h) + aoff + m * 2048 + k * 1024); } while (0)
#define PG8_LDB(dst, b, h) do { _Pragma("unroll") for (int n = 0; n < 2; ++n) _Pragma("unroll") for (int k = 0; k < 2; ++k) dst[n][k] = *(const PG8_LAS bf16x8*)(lds + PG8_SB(b, h) + boff + n * 2048 + k * 1024); } while (0)
#define PG8_MMA(ai, bj, At, Bt) do { __builtin_amdgcn_s_setprio(1); _Pragma("unroll") for (int m = 0; m < 4; ++m) _Pragma("unroll") for (int n = 0; n < 2; ++n) _Pragma("unroll") for (int k = 0; k < 2; ++k) \
        acc[ai][bj][m][n] = __builtin_amdgcn_mfma_f32_16x16x32_bf16(Bt[n][k], At[m][k], acc[ai][bj][m][n], 0, 0, 0); __builtin_amdgcn_s_setprio(0); } while (0)
#define PG8_WAIT_V(n) asm volatile("s_waitcnt vmcnt(" #n ")" ::: "memory")
#define PG8_WAIT_L(n) asm volatile("s_waitcnt lgkmcnt(" #n ")" ::: "memory")
#define PG8_BAR __builtin_amdgcn_s_barrier()
#define PG8_SCHED __builtin_amdgcn_sched_barrier(0)
    Unit cur, nxt; int ui = 0;
    if (!S.next(0, cur)) return;
    f32x4 acc[2][2][4][2];
#pragma unroll
    for (int a = 0; a < 2; ++a)
#pragma unroll
        for (int b = 0; b < 2; ++b)
#pragma unroll
            for (int m = 0; m < 4; ++m)
#pragma unroll
                for (int n = 0; n < 2; ++n) acc[a][b][m][n] = (f32x4){0.f, 0.f, 0.f, 0.f};
    bf16x8 At[4][2], B0[2][2], B1[2][2];
    const char* cA = (const char*)g.A + (size_t)cur.pm * tstep; const char* cB = (const char*)g.Bt + (size_t)cur.pn * tstep;
    S.a_ready(cur);
    if constexpr (SP2) {
        PG8_STAGE(PG8_SB(0, 0), cB, voffB); PG8_STAGE(PG8_SB(0, 1), cB + hstep, voffB); PG8_STAGE(PG8_SA(0, 0), cA, voffA); PG8_STAGE(PG8_SA(0, 1), cA + hstep, voffA);
        if (wr == 1) PG8_BAR;
        PG8_WAIT_V(2); PG8_BAR;
        PG8_STAGE(PG8_SB(1, 0), cB + kstep, voffB); PG8_STAGE(PG8_SA(1, 0), cA + kstep, voffA); PG8_STAGE(PG8_SB(1, 1), cB + hstep + kstep, voffB);
        PG8_WAIT_V(6); PG8_BAR;
    } else {
        PG8_STAGE(PG8_SB(0, 0), cB, voffB); PG8_STAGE(PG8_SA(0, 0), cA, voffA); PG8_STAGE(PG8_SB(0, 1), cB + hstep, voffB); PG8_STAGE(PG8_SA(0, 1), cA + hstep, voffA);
        if (wr == 1) PG8_BAR;
        PG8_WAIT_V(4); PG8_BAR;
        PG8_STAGE(PG8_SB(1, 0), cB + kstep, voffB); PG8_STAGE(PG8_SA(1, 0), cA + kstep, voffA); PG8_STAGE(PG8_SB(1, 1), cB + hstep + kstep, voffB);
        PG8_WAIT_V(6); PG8_BAR;
    }
    for (;;) {
        const bool has_next = S.next(ui + 1, nxt);
        const char* nA = has_next ? (const char*)g.A + (size_t)nxt.pm * tstep : cA; const char* nB = has_next ? (const char*)g.Bt + (size_t)nxt.pn * tstep : cB;
        for (int t = 0; t < nt; t += 2) {
            const bool last = (t == nt - 2);
            const char* a1 = cA + (size_t)(t + 1) * kstep;
            const char* a2 = last ? nA : cA + (size_t)(t + 2) * kstep; const char* b2 = last ? nB : cB + (size_t)(t + 2) * kstep;
            const char* a3 = a2 + kstep; const char* b3 = b2 + kstep;
            if (last && has_next) S.a_ready(nxt);
            if constexpr (SP2) {
            PG8_LDB(B0, 0, 0); PG8_LDB(B1, 0, 1); PG8_SCHED; PG8_LDA(At, 0, 0); PG8_STAGE(PG8_SA(1, 1), a1 + hstep, voffA);
            PG8_WAIT_V(8); PG8_WAIT_L(0); PG8_BAR; PG8_MMA(0, 0, At, B0); PG8_MMA(0, 1, At, B1); PG8_BAR; PG8_SCHED;
            PG8_LDA(At, 0, 1); PG8_STAGE(PG8_SB(0, 0), b2, voffB); PG8_STAGE(PG8_SB(0, 1), b2 + hstep, voffB); PG8_STAGE(PG8_SA(0, 0), a2, voffA);
            PG8_WAIT_V(8); PG8_WAIT_L(0); PG8_BAR; PG8_MMA(1, 0, At, B0); PG8_MMA(1, 1, At, B1); PG8_BAR; PG8_SCHED;
            PG8_LDB(B0, 1, 0); PG8_LDB(B1, 1, 1); PG8_SCHED; PG8_LDA(At, 1, 0); PG8_STAGE(PG8_SA(0, 1), a2 + hstep, voffA);
            PG8_WAIT_V(8); PG8_WAIT_L(0); PG8_BAR; PG8_MMA(0, 0, At, B0); PG8_MMA(0, 1, At, B1); PG8_BAR; PG8_SCHED;
            PG8_LDA(At, 1, 1); PG8_STAGE(PG8_SB(1, 0), b3, voffB); PG8_STAGE(PG8_SB(1, 1), b3 + hstep, voffB); PG8_STAGE(PG8_SA(1, 0), a3, voffA);
            PG8_WAIT_V(8); PG8_WAIT_L(0); PG8_BAR; PG8_MMA(1, 0, At, B0); PG8_MMA(1, 1, At, B1); PG8_BAR; PG8_SCHED;
            } else {
            PG8_LDB(B0, 0, 0); PG8_SCHED; PG8_LDA(At, 0, 0); PG8_STAGE(PG8_SA(1, 1), a1 + hstep, voffA);
            PG8_WAIT_L(8); PG8_BAR; PG8_WAIT_L(0); PG8_MMA(0, 0, At, B0); PG8_BAR; PG8_SCHED;
            PG8_LDB(B1, 0, 1); PG8_STAGE(PG8_SB(0, 0), b2, voffB);
            PG8_BAR; PG8_WAIT_L(0); PG8_MMA(0, 1, At, B1); PG8_BAR;
            PG8_LDA(At, 0, 1); PG8_STAGE(PG8_SA(0, 0), a2, voffA);
            PG8_BAR; PG8_WAIT_L(0); PG8_MMA(1, 0, At, B0); PG8_BAR; PG8_SCHED;
            PG8_STAGE(PG8_SB(0, 1), b2 + hstep, voffB);
            PG8_WAIT_V(6); PG8_BAR; PG8_MMA(1, 1, At, B1); PG8_BAR;
            PG8_LDB(B0, 1, 0); PG8_SCHED; PG8_LDA(At, 1, 0); PG8_STAGE(PG8_SA(0, 1), a2 + hstep, voffA);
            PG8_WAIT_L(8); PG8_BAR; PG8_WAIT_L(0); PG8_MMA(0, 0, At, B0); PG8_BAR; PG8_SCHED;
            PG8_LDB(B1, 1, 1); PG8_STAGE(PG8_SB(1, 0), b3, voffB);
            PG8_BAR; PG8_WAIT_L(0); PG8_MMA(0, 1, At, B1); PG8_BAR;
            PG8_LDA(At, 1, 1); PG8_STAGE(PG8_SA(1, 0), a3, voffA);
            PG8_BAR; PG8_WAIT_L(0); PG8_MMA(1, 0, At, B0); PG8_BAR; PG8_SCHED;
            PG8_STAGE(PG8_SB(1, 1), b3 + hstep, voffB);
            PG8_WAIT_V(6); PG8_BAR; PG8_MMA(1, 1, At, B1); PG8_BAR;
            }
        }
        if constexpr (ALIGN_EPI) { if (wr == 0) PG8_BAR; }
        if constexpr (!Epi::AFTER_DRAIN) { E(acc, cur, wr, wc, fr, fq); S.done(cur); }
        if (!has_next) break;
#pragma unroll
        for (int a = 0; a < 2; ++a)
#pragma unroll
            for (int b = 0; b < 2; ++b)
#pragma unroll
                for (int m = 0; m < 4; ++m)
#pragma unroll
                    for (int n = 0; n < 2; ++n) acc[a][b][m][n] = (f32x4){0.f, 0.f, 0.f, 0.f};
        cur = nxt; cA = nA; cB = nB; ++ui;
        if constexpr (ALIGN_EPI) { if (wr == 1) PG8_BAR; }
    }
    PG8_WAIT_V(0);
    if constexpr (!ALIGN_EPI) { if (wr == 0) PG8_BAR; }
    PG8_BAR;
    if constexpr (Epi::AFTER_DRAIN) { E.fused(acc, cur, wr, wc, fr, fq, lds, wid, lane); S.done(cur); }
#undef PG8_SA
#undef PG8_SB
#undef PG8_STAGE
#undef PG8_LDA
#undef PG8_LDB
#undef PG8_MMA
#undef PG8_WAIT_V
#undef PG8_WAIT_L
#undef PG8_BAR
#undef PG8_SCHED
}
}

struct EpiUp2 {
    static constexpr bool PERM = true, AFTER_DRAIN = false;
    const float* sumsq; bf16_t* U;
    DI void operator()(const pg8::f32x4 (&acc)[2][2][4][2], const pg8::Unit& u, int wr, int wc, int fr, int fq) const {
        const int row0 = u.pm * 256 + wr * 64 + fr, col0 = u.pn * 256 + wc * 32 + 8 * fq;
#pragma unroll
        for (int ai = 0; ai < 2; ++ai)
#pragma unroll
            for (int m = 0; m < 4; ++m) {
                const int row = row0 + ai * 128 + m * 16;
                bf16_t* rp = U + (size_t)row * 4096 + col0;
#pragma unroll
                for (int bj = 0; bj < 2; ++bj) {
                    float v[8];
#pragma unroll
                    for (int n = 0; n < 2; ++n)
#pragma unroll
                        for (int e = 0; e < 4; ++e) { const float t = fmaxf(acc[ai][bj][m][n][e], 0.f); v[4 * n + e] = t * t; }
                    u32x4 w; w.x = pk_bf16(v[0], v[1]); w.y = pk_bf16(v[2], v[3]); w.z = pk_bf16(v[4], v[5]); w.w = pk_bf16(v[6], v[7]);
                    *(u32x4*)(rp + bj * 128) = w;
                }
            }
    }
};

struct EpiRes2 {
    static constexpr bool PERM = true, AFTER_DRAIN = false;
    const float* resid; float* hout; bf16_t* hb; float* sumsq_next; const float* sumsq_in;
    DI void operator()(const pg8::f32x4 (&acc)[2][2][4][2], const pg8::Unit& u, int wr, int wc, int fr, int fq) const {
        const int row0 = u.pm * 256 + wr * 64 + fr, col0 = u.pn * 256 + wc * 32 + 8 * fq;
#pragma unroll
        for (int ai = 0; ai < 2; ++ai)
#pragma unroll
            for (int m = 0; m < 4; ++m) {
                const int row = row0 + ai * 128 + m * 16; float ss = 0.f;
                const float r2 = sumsq_in ? 1.0f / (sumsq_in[row] * (1.0f / 1024.0f) + EPS) : 1.0f;
#pragma unroll
                for (int bj = 0; bj < 2; ++bj) {
                    const size_t off = (size_t)row * 1024 + col0 + bj * 128;
                    f32x4 r0 = *(const f32x4*)(resid + off), r1 = *(const f32x4*)(resid + off + 4);
#pragma unroll
                    for (int e = 0; e < 4; ++e) { r0[e] += acc[ai][bj][m][0][e] * r2; r1[e] += acc[ai][bj][m][1][e] * r2; ss += r0[e] * r0[e] + r1[e] * r1[e]; }
                    *(f32x4*)(hout + off) = r0; *(f32x4*)(hout + off + 4) = r1;
                    u32x4 w; w.x = pk_bf16(r0[0], r0[1]); w.y = pk_bf16(r0[2], r0[3]); w.z = pk_bf16(r1[0], r1[1]); w.w = pk_bf16(r1[2], r1[3]);
                    if (hb) *(u32x4*)(hb + off) = w;
                }
                ss += __shfl_xor(ss, 16); ss += __shfl_xor(ss, 32);
                if (fq == 0) __hip_atomic_fetch_add(sumsq_next + row, ss, __ATOMIC_RELAXED, __HIP_MEMORY_SCOPE_AGENT);
                asm volatile("" ::: "memory");
            }
    }
};

DI void rope8(float (&v)[8], const float* __restrict__ rope, int s, int fq) {
    const f32x4 c0 = *(const f32x4*)(rope + s * 16), c1 = *(const f32x4*)(rope + s * 16 + 4), s0 = *(const f32x4*)(rope + s * 16 + 8), s1 = *(const f32x4*)(rope + s * 16 + 12);
    const float cs[8] = {c0[0], c0[1], c0[2], c0[3], c1[0], c1[1], c1[2], c1[3]}, sn[8] = {s0[0], s0[1], s0[2], s0[3], s1[0], s1[1], s1[2], s1[3]};
#pragma unroll
    for (int e = 0; e < 8; ++e) {
        const float other = __shfl_xor(v[e], 16);
        const float a = v[e] * cs[e], bq = other * sn[e];
        v[e] = (fq == 0) ? (a - bq) : ((fq == 1) ? (a + bq) : v[e]);
    }
}

struct EpiProj0b {
    static constexpr bool PERM = true, AFTER_DRAIN = false;
    const float* sumsq; bf16_t* P; bf16_t* vta; bf16_t* vtf; float* logf; const float* bfg; const float* rope;
    DI void operator()(const pg8::f32x4 (&acc)[2][2][4][2], const pg8::Unit& u, int wr, int wc, int fr, int fq) const {
        const int row0 = u.pm * 256 + wr * 64 + fr;
#pragma unroll
        for (int bj = 0; bj < 2; ++bj) {
            const int cb = u.pn * 256 + bj * 128;
            if (cb > 3072) continue;
            if (cb == 3072 && wc != 0) continue;
            const int col0 = cb + wc * 32 + 8 * fq;
            const int region = cb >> 9;
#pragma unroll
            for (int ai = 0; ai < 2; ++ai)
#pragma unroll
                for (int m = 0; m < 4; ++m) {
                    const int row = row0 + ai * 128 + m * 16;
                    const float rstd = rsqrtf(sumsq[row] * (1.0f / 1024.0f) + EPS);
                    const int s = row & (SEQ - 1), b = row >> 13;
                    float v[8];
#pragma unroll
                    for (int n = 0; n < 2; ++n)
#pragma unroll
                        for (int e = 0; e < 4; ++e) v[4 * n + e] = acc[ai][bj][m][n][e] * rstd;
                    if (cb == 3072) {
                        if (fq == 0) {
                            f32x4 o0, o1;
#pragma unroll
                            for (int e = 0; e < 4; ++e) {
                                const float x0 = v[e] + bfg[e], x1 = v[4 + e] + bfg[4 + e];
                                o0[e] = fminf(x0, 0.f) - __logf(1.0f + __expf(-fabsf(x0))); o1[e] = fminf(x1, 0.f) - __logf(1.0f + __expf(-fabsf(x1)));
                            }
                            *(f32x4*)(logf + (size_t)row * 8) = o0; *(f32x4*)(logf + (size_t)row * 8 + 4) = o1;
                        }
                    } else if (region == 2 || region == 5) {
                        const int c = col0 - region * 512;
                        bf16_t* vt = (region == 2 ? vta : vtf) + ((size_t)(b * 512 + c) * SEQ + s);
#pragma unroll
                        for (int e = 0; e < 8; ++e) vt[(size_t)e * SEQ] = to_bf16(v[e]);
                    } else {
                        if (region < 2 && (wc & 1) == 0) rope8(v, rope, s, fq);
                        const float qs = (region == 0 || region == 3) ? QSCALE : 1.0f;
                        u32x4 w; w.x = pk_bf16(v[0] * qs, v[1] * qs); w.y = pk_bf16(v[2] * qs, v[3] * qs); w.z = pk_bf16(v[4] * qs, v[5] * qs); w.w = pk_bf16(v[6] * qs, v[7] * qs);
                        *(u32x4*)(P + (size_t)row * P0_PITCH + col0) = w;
                    }
                    asm volatile("" ::: "memory");
                }
        }
    }
};

struct EpiProj1b {
    static constexpr bool PERM = true, AFTER_DRAIN = false;
    const float* sumsq; bf16_t* P; bf16_t* vt1; float* ikraw; float* iw; const float* rope;
    DI void operator()(const pg8::f32x4 (&acc)[2][2][4][2], const pg8::Unit& u, int wr, int wc, int fr, int fq) const {
        const int row0 = u.pm * 256 + wr * 64 + fr;
#pragma unroll
        for (int bj = 0; bj < 2; ++bj) {
            const int cb = u.pn * 256 + bj * 128;
            if (cb > 3584) continue;
            if (cb == 3584 && wc == 3) continue;
            const int col0 = cb + wc * 32 + 8 * fq;
#pragma unroll
            for (int ai = 0; ai < 2; ++ai)
#pragma unroll
                for (int m = 0; m < 4; ++m) {
                    const int row = row0 + ai * 128 + m * 16;
                    const float rstd = rsqrtf(sumsq[row] * (1.0f / 1024.0f) + EPS);
                    const int s = row & (SEQ - 1), b = row >> 13;
                    float v[8];
#pragma unroll
                    for (int n = 0; n < 2; ++n)
#pragma unroll
                        for (int e = 0; e < 4; ++e) v[4 * n + e] = acc[ai][bj][m][n][e] * rstd;
                    if (cb == 3584) {
                        if (wc < 2) {
                            float* d = ikraw + (size_t)row * 64 + wc * 32 + 8 * fq;
                            *(f32x4*)d = (f32x4){v[0], v[1], v[2], v[3]}; *(f32x4*)(d + 4) = (f32x4){v[4], v[5], v[6], v[7]};
                        } else if (fq == 0) {
                            const float sc = 0.044194173824159216f;
                            *(f32x4*)(iw + (size_t)row * 8) = (f32x4){v[0] * sc, v[1] * sc, v[2] * sc, v[3] * sc}; *(f32x4*)(iw + (size_t)row * 8 + 4) = (f32x4){v[4] * sc, v[5] * sc, v[6] * sc, v[7] * sc};
                        }
                    } else if (cb >= 2048 && cb < 3072) {
                        const int c = col0 - 2048;
                        bf16_t* vt = vt1 + ((size_t)(b * 1024 + c) * SEQ + s);
#pragma unroll
                        for (int e = 0; e < 8; ++e) vt[(size_t)e * SEQ] = to_bf16(v[e]);
                    } else {
                        if ((wc & 1) == 0) rope8(v, rope, s, fq);
                        const float qs = (cb < 1024) ? QSCALE : 1.0f;
                        u32x4 w; w.x = pk_bf16(v[0] * qs, v[1] * qs); w.y = pk_bf16(v[2] * qs, v[3] * qs); w.z = pk_bf16(v[4] * qs, v[5] * qs); w.w = pk_bf16(v[6] * qs, v[7] * qs);
                        *(u32x4*)(P + (size_t)row * P1_PITCH + col0) = w;
                    }
                    asm volatile("" ::: "memory");
                }
        }
    }
};

DI void phase_iknorm(const Params& p) {
    const int tid = threadIdx.x, lane = tid & 63, wid = tid >> 6;
    const float* ikraw = (const float*)(p.ws + WS_BITMASK);
    bf16_t* ikb = (bf16_t*)(p.ws + WS_IKB);
    const float* rope = (const float*)(p.ws + WS_ROPE);
    const float g = p.in[11][lane], bt = p.in[12][lane];
    for (int row = blockIdx.x * 8 + wid; row < T_TOK; row += gridDim.x * 8) {
        const float x = ikraw[(size_t)row * 64 + lane];
        const float mean = wave_sum(x) * (1.0f / 64.0f);
        const float d = x - mean;
        const float var = wave_sum(d * d) * (1.0f / 64.0f);
        float y = d * rsqrtf(var + EPS) * g + bt;
        const int s = row & (SEQ - 1);
        const float other = __shfl_xor(y, 8);
        const float cs = rope[s * 16 + (lane & 7)], sn = rope[s * 16 + 8 + (lane & 7)];
        if (lane < 8) y = y * cs - other * sn; else if (lane < 16) y = y * cs + other * sn;
        ikb[(size_t)row * 64 + lane] = to_bf16(y);
    }
}

DI void phase_scan(const Params& p, unsigned char* lds) {
    {
        const bf16_t* P = (const bf16_t*)(p.ws + WS_PBUF);
        unsigned* bnd = (unsigned*)(p.ws + WS_BND);
        for (int u = blockIdx.x; u < 256; u += gridDim.x) {
            const int bh = u >> 3, b = bh >> 3, h = bh & 7, chunk = u & 7;
            float qm = 0.f, km = 0.f;
#pragma unroll
            for (int j = 0; j < 2; ++j) {
                const int s = chunk * 1024 + j * 512 + (int)threadIdx.x;
                const bf16_t* row = P + (size_t)(b * SEQ + s) * P0_PITCH + h * 64;
                float qs = 0.f, ks = 0.f;
#pragma unroll
                for (int c = 0; c < 8; ++c) {
                    const u32x4 qv = *(const u32x4*)(row + 1536 + c * 8), kv = *(const u32x4*)(row + 2048 + c * 8);
#pragma unroll
                    for (int e = 0; e < 4; ++e) {
                        const float q0 = __uint_as_float(qv[e] << 16), q1 = __uint_as_float(qv[e] & 0xffff0000u);
                        const float k0 = __uint_as_float(kv[e] << 16), k1 = __uint_as_float(kv[e] & 0xffff0000u);
                        qs += q0 * q0 + q1 * q1; ks += k0 * k0 + k1 * k1;
                    }
                }
                qm = fmaxf(qm, qs); km = fmaxf(km, ks);
            }
#pragma unroll
            for (int d = 32; d >= 1; d >>= 1) { qm = fmaxf(qm, __shfl_xor(qm, d)); km = fmaxf(km, __shfl_xor(km, d)); }
            if ((threadIdx.x & 63) == 0) { atomicMax(bnd + bh * 2, __float_as_uint(qm)); atomicMax(bnd + bh * 2 + 1, __float_as_uint(km)); }
        }
    }
    const float* logf = (const float*)(p.ws + WS_LOGF);
    float* c2 = (float*)(p.ws + WS_C2);
    float* wsum = (float*)lds;
    const int tid = threadIdx.x, lane = tid & 63, wid = tid >> 6;
    for (int u = blockIdx.x; u < 32; u += gridDim.x) {
        const int b = u >> 3, h = u & 7;
        float v[16]; float tot = 0.f;
#pragma unroll
        for (int j = 0; j < 16; ++j) { v[j] = logf[((size_t)b * SEQ + tid * 16 + j) * 8 + h]; tot += v[j]; v[j] = tot; }
        float inc = tot;
#pragma unroll
        for (int d = 1; d < 64; d <<= 1) { const float o = __shfl_up(inc, d); if (lane >= d) inc += o; }
        if (lane == 63) wsum[wid] = inc;
        __syncthreads();
        float base = inc - tot;
        for (int w = 0; w < wid; ++w) base += wsum[w];
#pragma unroll
        for (int j = 0; j < 16; ++j) c2[((size_t)(b * 8 + h)) * SEQ + tid * 16 + j] = (base + v[j]) * LOG2E;
        __syncthreads();
    }
}

template <int MODE, int DRY = 0>
DI void attn_phase(const Params& p, unsigned char* lds) {
    constexpr int DVB = (MODE == 0) ? 4 : 2;
    constexpr int QU = (MODE == 0) ? 128 : 256;
    constexpr int NH = (MODE == 0) ? 4 : (MODE == 1 ? 8 : 16);
    constexpr int NQB = SEQ / QU, NBH = 4 * NH, NUNITS = NQB * NBH;
    constexpr int NJ = (MODE == 0) ? 4 : 2, NKJ = NJ / 2;
    constexpr int VT_OFF = (MODE == 0) ? 18432 : 9216;
    constexpr int CK_OFF = 17920;
    constexpr int STG = (MODE == 0) ? 35840 : 18432;
    constexpr int XCH_OFF = 3 * 35840;
    const int tid = threadIdx.x, lane = tid & 63, wid = tid >> 6, r32 = lane & 31, hh = lane >> 5;
    const int lrow = tid >> 3, lkc = tid & 7;
    const int G = gridDim.x;
    unsigned char* ws = p.ws;
    const bf16_t* P = (const bf16_t*)(ws + WS_PBUF);
    const bf16_t* VT = (const bf16_t*)(ws + WS_VT) + (MODE == 1 ? (size_t)4 * 512 * SEQ : 0);
    bf16_t* mixed = (bf16_t*)(ws + WS_MIXED);
    const float* c2 = (const float*)(ws + WS_C2);
    const u64* bitmask = (const u64*)(ws + WS_BITMASK);
    constexpr int PITCH = (MODE == 2) ? P1_PITCH : P0_PITCH;
    float lam = 0.f;
    if (MODE == 0) {
        float d1 = 0.f, d2 = 0.f;
        for (int i = 0; i < 64; ++i) { d1 += p.in[4][i] * p.in[5][i]; d2 += p.in[6][i] * p.in[7][i]; }
        lam = expf(d1) - expf(d2) + 0.2f;
    }
    for (int it = 0; it * G < NUNITS; ++it) {
        int qb, bh;
        if (MODE == 1 && G == 256) {
            const int p_ = (int)blockIdx.x, hbase = p_ & 7, bsel = (p_ >> 3) & 3, qgrp = p_ >> 5;
            qb = 8 * (3 - it) + qgrp; bh = bsel * 8 + ((hbase + 3 * it) & 7);
        } else {
            const int pos = (it & 1) ? (G - 1 - (int)blockIdx.x) : (int)blockIdx.x;
            const int u = it * G + pos;
            if (u >= NUNITS) continue;
            qb = NQB - 1 - u / NBH; bh = u % NBH;
        }
        const int b = bh / NH, h = bh % NH;
        const int q0 = qb * QU;
        const int cmap = (MODE == 0) ? (wid >> 2) : 0;
        const int qw0 = q0 + 32 * ((MODE == 0) ? (wid & 3) : wid);
        const int nt = (q0 + QU) >> 6;
        const int myq = qw0 + r32;
        int j0 = 0;
        if (MODE == 1) {
            const unsigned* bnd = (const unsigned*)(ws + WS_BND) + (b * 8 + h) * 2;
            const float Bnd = sqrtf(__uint_as_float(bnd[0]) * __uint_as_float(bnd[1])) * 1.02f + 0.5f;
            const float thr = -(2.0f * Bnd + 30.0f);
            const float* cc = c2 + (size_t)(b * 8 + h) * SEQ;
            const float cq0 = cc[q0];
            int lo = 0, hi = q0 >> 6;
            while (lo < hi) { const int mid = (lo + hi) >> 1; if (cq0 - cc[64 * mid + 63] >= thr) hi = mid; else lo = mid + 1; }
            j0 = lo;
        }
        const int ntl = nt - j0;
        const bf16_t* src[NJ]; size_t step[NJ];
        if (MODE == 0) {
            src[0] = P + (size_t)(b * SEQ + lrow) * PITCH + 512 + (h * 2) * 64 + lkc * 8; step[0] = (size_t)64 * PITCH;
            src[1] = src[0] + 64; step[1] = step[0];
            src[2] = VT + (size_t)(b * 512 + h * 128 + lrow) * SEQ + lkc * 8; step[2] = 64;
            src[3] = src[2] + (size_t)64 * SEQ; step[3] = 64;
        } else if (MODE == 1) {
            src[0] = P + (size_t)(b * SEQ + lrow) * PITCH + 2048 + h * 64 + lkc * 8; step[0] = (size_t)64 * PITCH;
            src[1] = VT + (size_t)(b * 512 + h * 64 + lrow) * SEQ + lkc * 8; step[1] = 64;
        } else {
            src[0] = P + (size_t)(b * SEQ + lrow) * PITCH + 1024 + h * 64 + lkc * 8; step[0] = (size_t)64 * PITCH;
            src[1] = VT + (size_t)(b * 1024 + h * 64 + lrow) * SEQ + lkc * 8; step[1] = 64;
        }
        const int qcol = (MODE == 0) ? (h * 2 + cmap) * 64 : (MODE == 1 ? 1536 + h * 64 : h * 64);
        bf16x8 qf[4];
#pragma unroll
        for (int ks = 0; ks < 4; ++ks) qf[ks] = *(const bf16x8*)(P + (size_t)(b * SEQ + myq) * PITCH + qcol + 16 * ks + 8 * hh);
        const float* ckp = nullptr;
        if (MODE == 1) ckp = c2 + (size_t)(b * 8 + h) * SEQ;
        const u64* mrow = nullptr; u64 wcur = 0, wnext = 0, wnext2 = 0;
        if (MODE == 2) { mrow = bitmask + (size_t)(b * SEQ + myq) * 128; wcur = mrow[0]; }
        f32x16 o[DVB];
#pragma unroll
        for (int db = 0; db < DVB; ++db)
#pragma unroll
            for (int i = 0; i < 16; ++i) o[db][i] = 0.f;
        float m = -1e30f, l = 0.f;
        constexpr bool DEEP = (MODE != 0);
        u32x4 rgE[NJ], rgO[NJ]; float ckrE = 0.f, ckrO = 0.f;
        auto gload = [&](u32x4 (&rg)[NJ], float& ckr, int t) {
#pragma unroll
            for (int j = 0; j < NJ; ++j) rg[j] = *(const u32x4*)(src[j] + (size_t)t * step[j]);
            if (MODE == 1 && tid < 64) ckr = ckp[t * 64 + tid];
        };
        auto lstore = [&](const u32x4 (&rg)[NJ], const float ckr, int stg) {
            unsigned char* sb = lds + stg * STG;
#pragma unroll
            for (int j = 0; j < NJ; ++j) {
                if (j < NKJ) *(u32x4*)(sb + j * 9216 + lrow * 144 + lkc * 16) = rg[j];
                else { unsigned char* d = sb + VT_OFF + (lrow + 64 * (j - NKJ)) * 136 + lkc * 16; u32x2 a, c; a.x = rg[j].x; a.y = rg[j].y; c.x = rg[j].z; c.y = rg[j].w; *(u32x2*)d = a; *(u32x2*)(d + 8) = c; }
            }
            if (MODE == 1 && tid < 64) *(float*)(sb + CK_OFF + tid * 4) = ckr;
        };
        const unsigned koff = cmap * 9216 + r32 * 144 + hh * 16;
        const unsigned voff = VT_OFF + r32 * 136 + hh * 8;
        auto qk = [&](f32x16 (&s)[2], float& mi, int stg) {
            const unsigned char* kb_ = lds + stg * STG + koff;
            const unsigned mb = pk_bf16((m > -1e29f) ? -m : 0.f, 0.f) & 0xffffu;
            mi = -__uint_as_float(mb << 16);
            u32x4 qxw; qxw.x = hh ? 0u : mb; qxw.y = 0u; qxw.z = 0u; qxw.w = 0u;
            u32x4 kxw; kxw.x = hh ? 0u : 0x3f80u; kxw.y = 0u; kxw.z = 0u; kxw.w = 0u;
            const bf16x8 qx = __builtin_bit_cast(bf16x8, qxw), kx = __builtin_bit_cast(bf16x8, kxw);
            f32x16 zero;
#pragma unroll
            for (int i = 0; i < 16; ++i) zero[i] = 0.f;
#pragma unroll
            for (int blk = 0; blk < 2; ++blk) {
                s[blk] = MFMA32(kx, qx, zero);
#pragma unroll
                for (int ks = 0; ks < 4; ++ks) {
                    const bf16x8 kf = *(const bf16x8*)(kb_ + blk * 4608 + ks * 32);
                    s[blk] = MFMA32(kf, qf[ks], s[blk]);
                }
            }
        };
        auto softmax_pv = [&](f32x16 (&s)[2], const float mi, int kt, int stg) {
            const int k0 = kt * 64;
            const unsigned char* sb = lds + stg * STG;
            if (DRY != 1) {
            if (MODE == 1) {
#pragma unroll
                for (int blk = 0; blk < 2; ++blk)
#pragma unroll
                    for (int g = 0; g < 4; ++g) {
                        const f32x4 c4 = *(const f32x4*)(sb + CK_OFF + (32 * blk + 8 * g + 4 * hh) * 4);
#pragma unroll
                        for (int e = 0; e < 4; ++e) s[blk][4 * g + e] -= c4[e];
                    }
            }
            if (MODE == 2) {
                const u64 wsh = wcur >> (4 * hh);
                const int wlo = (int)(unsigned)wsh, whi = (int)(unsigned)(wsh >> 32);
#pragma unroll
                for (int i = 0; i < 16; ++i) {
                    const int bit = (i & 3) + 8 * (i >> 2);
                    const unsigned m0 = (unsigned)__builtin_amdgcn_sbfe(wlo, bit, 1), m1 = (unsigned)__builtin_amdgcn_sbfe(whi, bit, 1);
                    s[0][i] = __uint_as_float((__float_as_uint(s[0][i]) & m0) | (0xff800000u & ~m0));
                    s[1][i] = __uint_as_float((__float_as_uint(s[1][i]) & m1) | (0xff800000u & ~m1));
                }
            } else if (k0 + 63 > qw0) {
#pragma unroll
                for (int blk = 0; blk < 2; ++blk)
#pragma unroll
                    for (int i = 0; i < 16; ++i) { const int key = k0 + 32 * blk + crow(i, hh); if (key > myq) s[blk][i] = -INFINITY; }
            }
            float mx = s[0][0];
#pragma unroll
            for (int i = 1; i < 16; ++i) mx = fmaxf(mx, s[0][i]);
#pragma unroll
            for (int i = 0; i < 16; ++i) mx = fmaxf(mx, s[1][i]);
            mx = xhalf_max(mx);
            const float mabs = mi + mx;
            const bool up = mabs > m + 8.0f;
            const float mn = up ? __uint_as_float(pk_bf16(mabs, 0.f) << 16) : m;
            const float shift = mn - mi;
            if (__ballot(shift != 0.f) != 0) {
                if (__ballot(up) != 0) {
                    const float alpha = __builtin_amdgcn_exp2f(m - mn);
                    l *= alpha;
#pragma unroll
                    for (int db = 0; db < DVB; ++db)
#pragma unroll
                        for (int i = 0; i < 16; ++i) o[db][i] *= alpha;
                    m = mn;
                }
#pragma unroll
                for (int blk = 0; blk < 2; ++blk)
#pragma unroll
                    for (int i = 0; i < 16; ++i) s[blk][i] -= shift;
            }
            float ls = 0.f;
#pragma unroll
            for (int blk = 0; blk < 2; ++blk)
#pragma unroll
                for (int i = 0; i < 16; ++i) { const float e = __builtin_amdgcn_exp2f(s[blk][i]); s[blk][i] = e; ls += e; }
            l += ls;
            }
#pragma unroll
            for (int blk = 0; blk < 2; ++blk)
#pragma unroll
                for (int sp = 0; sp < 2; ++sp) {
                    u32x4 pw;
                    pw.x = pk_bf16(s[blk][8 * sp + 0], s[blk][8 * sp + 1]); pw.y = pk_bf16(s[blk][8 * sp + 2], s[blk][8 * sp + 3]);
                    pw.z = pk_bf16(s[blk][8 * sp + 4], s[blk][8 * sp + 5]); pw.w = pk_bf16(s[blk][8 * sp + 6], s[blk][8 * sp + 7]);
                    const bf16x8 pf = __builtin_bit_cast(bf16x8, pw);
#pragma unroll
                    for (int db = 0; db < DVB; ++db) {
                        const unsigned char* va = sb + voff + db * 32 * 136 + (32 * blk + 16 * sp) * 2;
                        const u32x2 lo = *(const u32x2*)va, hi = *(const u32x2*)(va + 16);
                        u32x4 vw; vw.x = lo.x; vw.y = lo.y; vw.z = hi.x; vw.w = hi.y;
                        o[db] = MFMA32(__builtin_bit_cast(bf16x8, vw), pf, o[db]);
                    }
                }
        };
        auto stepf = [&](f32x16 (&s_cur)[2], const float mi_cur, f32x16 (&s_nxt)[2], float& mi_nxt, u32x4 (&rg_ld)[NJ], float& ck_ld, const u32x4 (&rg_st)[NJ], const float ck_st, int kk) {
            const int kt = j0 + kk;
            if (DEEP) { if (kk + 3 < ntl) gload(rg_ld, ck_ld, kt + 3); } else { if (kk + 2 < ntl) gload(rg_ld, ck_ld, kt + 2); }
            if (MODE == 2 && kk + 2 < ntl) wnext2 = mrow[kt + 2];
            if (kk + 1 < ntl && (kt + 1) * 64 <= qw0 + 31) qk(s_nxt, mi_nxt, (kk + 1) % 3);
            if (kt * 64 <= qw0 + 31) softmax_pv(s_cur, mi_cur, kt, kk % 3);
            if (MODE == 2) { wcur = wnext; wnext = wnext2; }
            if (kk + 2 < ntl) lstore(rg_st, ck_st, (kk + 2) % 3);
            __syncthreads();
        };
        gload(rgE, ckrE, j0); lstore(rgE, ckrE, 0);
        if (ntl > 1) { gload(rgE, ckrE, j0 + 1); lstore(rgE, ckrE, 1); }
        if (DEEP && ntl > 2) gload(rgO, ckrO, j0 + 2);
        if (MODE == 2 && ntl > 1) wnext = mrow[j0 + 1];
        __syncthreads();
        f32x16 sA[2], sB[2]; float miA = 0.f, miB = 0.f;
        if (j0 * 64 <= qw0 + 31) qk(sA, miA, 0);
        for (int kk = 0; kk < ntl; kk += 2) {
            if (DEEP) {
                stepf(sA, miA, sB, miB, rgE, ckrE, rgO, ckrO, kk);
                if (kk + 1 < ntl) stepf(sB, miB, sA, miA, rgO, ckrO, rgE, ckrE, kk + 1);
            } else {
                stepf(sA, miA, sB, miB, rgE, ckrE, rgE, ckrE, kk);
                if (kk + 1 < ntl) stepf(sB, miB, sA, miA, rgE, ckrE, rgE, ckrE, kk + 1);
            }
        }
        l = xhalf_sum(l);
        const float inv = 1.0f / l;
        const int tok = b * SEQ + myq;
        if (DRY != 0 && o[0][0] != 12345.678f) continue;
        if (MODE == 0) {
            float* xch = (float*)(lds + XCH_OFF);
            const int qs = wid & 3;
#pragma unroll
            for (int db = 0; db < DVB; ++db) {
                if (cmap == 1) {
#pragma unroll
                    for (int i = 0; i < 16; ++i) xch[(qs * 16 + i) * 64 + lane] = o[db][i] * inv;
                }
                __syncthreads();
                if (cmap == 0) {
#pragma unroll
                    for (int i = 0; i < 16; ++i) o[db][i] = o[db][i] * inv - lam * xch[(qs * 16 + i) * 64 + lane];
                }
                __syncthreads();
            }
            if (cmap == 0) {
                float ss = 0.f;
#pragma unroll
                for (int db = 0; db < DVB; ++db)
#pragma unroll
                    for (int i = 0; i < 16; ++i) ss += o[db][i] * o[db][i];
                ss = xhalf_sum(ss);
                const float rn = rsqrtf(ss * (1.0f / 128.0f) + EPS) * 0.8f;
                const float* subg = p.in[8];
#pragma unroll
                for (int db = 0; db < DVB; ++db)
#pragma unroll
                    for (int g = 0; g < 4; ++g) {
                        const int d0 = 32 * db + 8 * g + 4 * hh;
                        const f32x4 gg = *(const f32x4*)(subg + d0);
                        store4_bf16(mixed + (size_t)tok * 1024 + h * 128 + d0, o[db][4 * g] * rn * gg[0], o[db][4 * g + 1] * rn * gg[1], o[db][4 * g + 2] * rn * gg[2], o[db][4 * g + 3] * rn * gg[3]);
                    }
            }
        } else {
            const int cbase = (MODE == 1) ? 512 + h * 64 : h * 64;
#pragma unroll
            for (int db = 0; db < DVB; ++db)
#pragma unroll
                for (int g = 0; g < 4; ++g)
                    store4_bf16(mixed + (size_t)tok * 1024 + cbase + 32 * db + 8 * g + 4 * hh, o[db][4 * g] * inv, o[db][4 * g + 1] * inv, o[db][4 * g + 2] * inv, o[db][4 * g + 3] * inv);
        }
    }
}

DI unsigned sortable(float x) { if (x == 0.f) x = 0.f; const unsigned u = __float_as_uint(x); return (u & 0x80000000u) ? ~u : (u | 0x80000000u); }

DI void hist_select(const unsigned* hrow, int need, int lane, int& bsel, int& above, bool& hit) {
    const u32x4 w0 = *(const u32x4*)(hrow + 8 * lane), w1 = *(const u32x4*)(hrow + 8 * lane + 4);
    unsigned wv[8] = {w0.x, w0.y, w0.z, w0.w, w1.x, w1.y, w1.z, w1.w};
    int cnt[16]; int tot = 0;
#pragma unroll
    for (int j = 0; j < 8; ++j) { cnt[2 * j] = (int)(wv[j] & 0xffffu); cnt[2 * j + 1] = (int)(wv[j] >> 16); tot += cnt[2 * j] + cnt[2 * j + 1]; }
    int inc = tot;
#pragma unroll
    for (int d = 1; d < 64; d <<= 1) { const int o = __shfl_down(inc, d); if (lane + d < 64) inc += o; }
    const int exc = inc - tot;
    const bool pred = (inc >= need) && (exc < need);
    const u64 bal = __ballot(pred);
    int mybin = 0, myabove = exc; bool found = false; int run = exc;
#pragma unroll
    for (int j = 15; j >= 0; --j) { if (!found && run + cnt[j] >= need) { found = true; mybin = 16 * lane + j; myabove = run; } run += cnt[j]; }
    hit = (bal != 0);
    if (bal == 0) {
        const int total = __shfl(inc, 0), c0 = __shfl(cnt[0], 0);
        bsel = 0; above = total - c0;
    } else {
        const int L = __ffsll((long long)bal) - 1;
        bsel = __shfl(mybin, L); above = __shfl(myabove, L);
    }
}

template <int N> struct IC { static constexpr int value = N; };

DI void phase_index(const Params& p, unsigned char* lds) {
    constexpr int NUNITS = 4 * 256;
    constexpr int TILE_OFF = 65536, STAGE_B = 36864, INFO_OFF = 65536 + 2 * 36864;
    const int tid = threadIdx.x, lane = tid & 63, wid = tid >> 6, r32 = lane & 31, hh = lane >> 5;
    const int lrow = tid >> 3, lkc = tid & 7;
    const int G = gridDim.x;
    unsigned char* ws = p.ws;
    const bf16_t* P = (const bf16_t*)(ws + WS_PBUF);
    const bf16_t* ikb = (const bf16_t*)(ws + WS_IKB);
    const float* iw = (const float*)(ws + WS_IW);
    u64* bitmask = (u64*)(ws + WS_BITMASK);
    unsigned* hist = (unsigned*)lds;
    int* info = (int*)(lds + INFO_OFF);
    for (int it = 0; it * G < NUNITS; ++it) {
        const int pos = (it & 1) ? (G - 1 - (int)blockIdx.x) : (int)blockIdx.x;
        const int u = it * G + pos;
        if (u >= NUNITS) continue;
        const int qblk = 255 - (u >> 2), b = u & 3;
        const int t0 = qblk * 32;
        const int nt = (t0 >> 6) + 1;
        const int nst = (nt + 3) >> 2;
        bf16x8 qf[4];
        {
            const bf16_t* qp = P + (size_t)(b * SEQ + t0 + 4 * wid + (r32 >> 3)) * P1_PITCH + 3072 + (r32 & 7) * 64 + 8 * hh;
#pragma unroll
            for (int ks = 0; ks < 4; ++ks) qf[ks] = *(const bf16x8*)(qp + 16 * ks);
        }
        f32x4 wq[4];
#pragma unroll
        for (int q = 0; q < 4; ++q) wq[q] = *(const f32x4*)(iw + (size_t)(b * SEQ + t0 + 4 * wid + q) * 8 + 4 * hh);
        const bf16_t* srcp = ikb + (size_t)(b * SEQ + lrow) * 64 + lkc * 8;
        const unsigned st_off = TILE_OFF + lrow * 144 + lkc * 16;
        const unsigned rd_off = TILE_OFF + r32 * 144 + hh * 16;
        int b1v[2] = {0, 0}, tauv[2] = {0, 0};
        int rq[4] = {0, 0, 0, 0}, cntq[4] = {0, 0, 0, 0};
        const unsigned hbase0 = (unsigned)(4 * wid + 2 * hh) * 2048u;
        const int tq0 = t0 + 4 * wid + 2 * hh;
        u64 Gm[4], Em[4];
        int cntA[2] = {0, 0}; int hiv[2] = {0, 0}, sbv[2] = {8, 8}, kshv[2] = {12, 12};
        auto mma = [&](f32x16& s, unsigned off) {
#pragma unroll
            for (int i = 0; i < 16; ++i) s[i] = 0.f;
#pragma unroll
            for (int ks = 0; ks < 4; ++ks) { const bf16x8 kf = *(const bf16x8*)(lds + off + ks * 32); s = MFMA32(qf[ks], kf, s); }
        };
        auto proc = [&](auto PASSC, auto DIAGC, const f32x16& s, int k0, int kb) {
            constexpr int PASS = decltype(PASSC)::value; constexpr bool DIAG = decltype(DIAGC)::value != 0;
            f32x4 tot;
#pragma unroll
            for (int q = 0; q < 4; ++q) {
                float pr = 0.f;
#pragma unroll
                for (int e = 0; e < 4; ++e) pr += wq[q][e] * fmaxf(s[4 * q + e], 0.f);
                tot[q] = xhalf_sum(pr);
            }
            const int key = k0 + 32 * kb + r32;
#pragma unroll
            for (int qq = 0; qq < 2; ++qq) {
                const float t_lo = tot[qq], t_hi = tot[2 + qq];
                const float sc = ((lane & 32) ? t_hi : t_lo) + 0.0f;
                const unsigned ub = __float_as_uint(sc);
                const unsigned uk = ub ^ ((unsigned)((int)ub >> 31) | 0x80000000u);
                const bool valid = DIAG ? (key <= tq0 + qq) : true;
                if (PASS == 0) {
                    if (valid) { const unsigned a = (uk >> 21) & 0x7feu; atomicAdd((unsigned*)(lds + hbase0 + qq * 2048 + (a & ~3u)), 1u << ((a & 2u) << 3)); }
                } else if (PASS == 1) {
                    if (valid && (int)(uk >> 22) == b1v[qq]) { const unsigned a = (uk >> 11) & 0x7feu; atomicAdd((unsigned*)(lds + hbase0 + qq * 2048 + (a & ~3u)), 1u << ((a & 2u) << 3)); }
                } else if (PASS == 3) {
                    if (valid) {
                        const int k10 = (int)(uk >> 22), d = k10 - b1v[qq];
                        if (k10 > hiv[qq]) cntA[qq] += 1;
                        else if (d >= 0) {
                            const unsigned bin = ((unsigned)d << sbv[qq]) | ((uk >> (22 - sbv[qq])) & ((1u << sbv[qq]) - 1u));
                            const unsigned a = bin << 1;
                            atomicAdd((unsigned*)(lds + hbase0 + qq * 2048 + (a & ~3u)), 1u << ((a & 2u) << 3));
                        }
                    }
                } else {
                    const int k20 = (int)(uk >> kshv[qq]);
                    const u64 bg = __ballot(valid && k20 > tauv[qq]);
                    const u64 be = __ballot(valid && k20 == tauv[qq]);
                    Gm[qq] |= (bg & 0xffffffffull) << (32 * kb); Gm[2 + qq] |= (bg >> 32) << (32 * kb);
                    Em[qq] |= (be & 0xffffffffull) << (32 * kb); Em[2 + qq] |= (be >> 32) << (32 * kb);
                }
            }
        };
        auto finish_tile = [&](int kt) {
#pragma unroll
            for (int q = 0; q < 4; ++q) {
                u64 take = Em[q];
                const int neq = __popcll(take);
                if (cntq[q] + neq > rq[q]) {
                    int keep = rq[q] - cntq[q]; if (keep < 0) keep = 0;
                    while (__popcll(take) > keep) take &= ~(1ull << (63 - __clzll((long long)take)));
                }
                cntq[q] += neq;
                const u64 fin = Gm[q] | take;
                if (lane == q) bitmask[(size_t)(b * SEQ + t0 + 4 * wid + q) * 128 + kt] = fin;
            }
        };
        auto run_pass = [&](auto PASSC, const bool samp) {
            constexpr int PASS = decltype(PASSC)::value;
            if (PASS == 3) { cntA[0] = 0; cntA[1] = 0; }
            if (PASS != 2) {
#pragma unroll
                for (int j = 0; j < 8; ++j) *(u32x4*)(lds + wid * 8192 + j * 1024 + lane * 16) = (u32x4){0u, 0u, 0u, 0u};
            }
            u32x4 rg[4];
#pragma unroll
            for (int j = 0; j < 4; ++j) rg[j] = *(const u32x4*)(srcp + (size_t)(64 * j) * 64);
            __syncthreads();
#pragma unroll
            for (int j = 0; j < 4; ++j) *(u32x4*)(lds + st_off + j * 9216) = rg[j];
            __syncthreads();
            for (int st = 0; st < nst; ++st) {
                const unsigned bufo = (st & 1) * STAGE_B;
                if (st + 1 < nst) {
#pragma unroll
                    for (int j = 0; j < 4; ++j) rg[j] = *(const u32x4*)(srcp + (size_t)((st + 1) * 256 + 64 * j) * 64);
                }
                const int nsub = samp ? 1 : ((nt - 4 * st) < 4 ? (nt - 4 * st) : 4);
                f32x16 sA, sB;
                mma(sA, rd_off + bufo);
                for (int sub = 0; sub < nsub; ++sub) {
                    const int kt = 4 * st + sub, k0 = kt * 64;
                    const unsigned toff = rd_off + bufo + sub * 9216;
                    if (PASS == 2) {
#pragma unroll
                        for (int q = 0; q < 4; ++q) { Gm[q] = 0; Em[q] = 0; }
                    }
                    mma(sB, toff + 4608);
                    if (kt == nt - 1) proc(PASSC, IC<1>{}, sA, k0, 0); else proc(PASSC, IC<0>{}, sA, k0, 0);
                    if (sub + 1 < nsub) mma(sA, toff + 9216);
                    if (kt == nt - 1) proc(PASSC, IC<1>{}, sB, k0, 1); else proc(PASSC, IC<0>{}, sB, k0, 1);
                    if (PASS == 2) finish_tile(kt);
                }
                if (st + 1 < nst) {
#pragma unroll
                    for (int j = 0; j < 4; ++j) *(u32x4*)(lds + st_off + (STAGE_B - bufo) + j * 9216) = rg[j];
                }
                __syncthreads();
            }
            if (PASS != 2) {
                int ca0 = cntA[0], ca1 = cntA[1];
                if (PASS == 3) {
#pragma unroll
                    for (int d = 1; d < 32; d <<= 1) { ca0 += __shfl_xor(ca0, d); ca1 += __shfl_xor(ca1, d); }
                }
#pragma unroll
                for (int q = 0; q < 4; ++q) {
                    const int ql = 4 * wid + q;
                    int need = 256;
                    if (PASS == 0) need = samp ? 64 : 256;
                    else if (PASS == 1) need = info[ql * 4 + 1];
                    else need = 256 - __shfl((q & 1) ? ca1 : ca0, 32 * (q >> 1));
                    int bsel, above; bool hit;
                    if (PASS == 0 && samp) {
                        int bhi, blo, ab2; bool h2;
                        hist_select(hist + ql * 512, 32, lane, bhi, above, hit);
                        hist_select(hist + ql * 512, 128, lane, blo, ab2, h2);
                        if (!h2) blo = 0;
                        const int nb = bhi - blo + 1;
                        int sb = 8; while (sb > 0 && (nb << sb) > 1024) --sb;
                        if (lane == 0) { info[ql * 4 + 0] = blo; info[ql * 4 + 1] = bhi; info[160 + ql] = sb; if ((nb << sb) > 1024) info[128] = 1; }
                    } else {
                    hist_select(hist + ql * 512, need > 0 ? need : 1, lane, bsel, above, hit);
                    if (lane == 0) {
                        if (PASS == 0) { info[ql * 4 + 0] = bsel; info[ql * 4 + 1] = need - above; }
                        else if (PASS == 1) { info[ql * 4 + 2] = (info[ql * 4 + 0] << 10) | bsel; info[ql * 4 + 3] = need - above; info[160 + ql] = 10; }
                        else {
                            if (need <= 0 || !hit) info[128] = 1;
                            const int sb = info[160 + ql];
                            info[ql * 4 + 2] = ((info[ql * 4 + 0] + (bsel >> sb)) << sb) | (bsel & ((1 << sb) - 1)); info[ql * 4 + 3] = need - above;
                        }
                    }
                    }
                }
                __syncthreads();
#pragma unroll
                for (int qq = 0; qq < 2; ++qq) { const int ql = 4 * wid + 2 * hh + qq; b1v[qq] = info[ql * 4 + 0]; hiv[qq] = info[ql * 4 + 1]; tauv[qq] = info[ql * 4 + 2]; sbv[qq] = info[160 + ql]; kshv[qq] = 22 - sbv[qq]; }
#pragma unroll
                for (int q = 0; q < 4; ++q) { rq[q] = info[(4 * wid + q) * 4 + 3]; cntq[q] = 0; }
            }
        };
        bool have = false;
        if (nt >= 16) {
            if (tid == 0) info[128] = 0;
            run_pass(IC<0>{}, true);
            run_pass(IC<3>{}, false);
            if (info[128] == 0) have = true;
        }
        if (!have) { run_pass(IC<0>{}, false); run_pass(IC<1>{}, false); }
        run_pass(IC<2>{}, false);
        __syncthreads();
    }
}

DI void phase_final(const Params& p) {
    const int tid = threadIdx.x, lane = tid & 63, wid = tid >> 6;
    const float* sumsq = (const float*)(p.ws + WS_SUMSQ) + 4 * T_TOK;
    const float* g = p.in[17];
    float* out = p.out;
    f32x4 gg[4];
#pragma unroll
    for (int j = 0; j < 4; ++j) gg[j] = *(const f32x4*)(g + 4 * lane + 256 * j);
    for (int r0 = (blockIdx.x * 8 + wid) * 4; r0 < T_TOK; r0 += gridDim.x * 8 * 4) {
        f32x4 xv[4][4];
#pragma unroll
        for (int rr = 0; rr < 4; ++rr)
#pragma unroll
            for (int j = 0; j < 4; ++j) xv[rr][j] = *(const f32x4*)(out + (size_t)(r0 + rr) * 1024 + 4 * lane + 256 * j);
#pragma unroll
        for (int rr = 0; rr < 4; ++rr) {
            const float rstd = rsqrtf(sumsq[r0 + rr] * (1.0f / 1024.0f) + EPS);
#pragma unroll
            for (int j = 0; j < 4; ++j) {
                f32x4 v = xv[rr][j];
#pragma unroll
                for (int e = 0; e < 4; ++e) v[e] = v[e] * rstd * gg[j][e];
                *(f32x4*)(out + (size_t)(r0 + rr) * 1024 + 4 * lane + 256 * j) = v;
            }
        }
    }
}

DI void gbar(unsigned* ctr, unsigned& gen, unsigned G) {
    asm volatile("s_waitcnt vmcnt(0)" ::: "memory");
    __syncthreads();
    gen += 1;
    if (threadIdx.x == 0) {
        __builtin_amdgcn_fence(__ATOMIC_RELEASE, "agent");
        asm volatile("s_waitcnt vmcnt(0)" ::: "memory");
        __hip_atomic_fetch_add(ctr, 1u, __ATOMIC_RELAXED, __HIP_MEMORY_SCOPE_AGENT);
        while (__hip_atomic_load(ctr, __ATOMIC_RELAXED, __HIP_MEMORY_SCOPE_AGENT) < gen * G) __builtin_amdgcn_s_sleep(12);
        __builtin_amdgcn_fence(__ATOMIC_ACQUIRE, "agent");
        asm volatile("s_waitcnt vmcnt(0)" ::: "memory");
    }
    __syncthreads();
}

__global__ void __launch_bounds__(NTHREADS) fwd_megakernel(Params p) {
    extern __shared__ __attribute__((aligned(16))) unsigned char lds[];
    cg::grid_group grid = cg::this_grid();
    unsigned char* ws = p.ws;
    float* sumsq = (float*)(ws + WS_SUMSQ);
    bf16_t* hb = (bf16_t*)(ws + WS_HB);
    bf16_t* pbuf = (bf16_t*)(ws + WS_PBUF);
    bf16_t* vt = (bf16_t*)(ws + WS_VT);
    bf16_t* mixed = (bf16_t*)(ws + WS_MIXED);
    bf16_t* U = (bf16_t*)(ws + WS_PBUF);
    const float* rope = (const float*)(ws + WS_ROPE);
#define PH(k) if (p.ph_lo <= (k) && (k) < p.ph_hi)
    unsigned bgen = 0; unsigned* bctr = (unsigned*)(ws + WS_BAR);
#define SYNC(k) if (p.ph_lo <= (k) && (k) + 1 < p.ph_hi) { if ((k) == 0) grid.sync(); else gbar(bctr, bgen, gridDim.x); }
#define GEMM(EPI, e, A_, W_, N_, K_) { pg8::Gemm g{A_, W_, T_TOK, N_, K_}; pg8::StaticOrder S; S.init(T_TOK, N_, (int)gridDim.x, (int)blockIdx.x); \
        pg8::gemm_phase<EPI, pg8::StaticOrder, true, true>(l3, g, S, e); }
    PG8_LAS unsigned char* l3 = (PG8_LAS unsigned char*)lds;
    PH(0) phase_prep(p, lds);
    if (REP_PH == 0) PH(0) phase_prep(p, lds);
    SYNC(0)
    PH(1) { EpiProj0b e{sumsq, pbuf, vt, vt + (size_t)4 * 512 * SEQ, (float*)(ws + WS_LOGF), p.in[3], rope}; GEMM(EpiProj0b, e, hb, (const bf16_t*)(ws + WS_WT_IN0), 3072, 1024) }
    if (REP_PH == 1) PH(1) { EpiProj0b e{sumsq, pbuf, vt, vt + (size_t)4 * 512 * SEQ, (float*)(ws + WS_LOGF), p.in[3], rope}; GEMM(EpiProj0b, e, hb, (const bf16_t*)(ws + WS_WT_IN0), 3072, 1024) }
    SYNC(1)
    PH(2) phase_scan(p, lds);
    if (REP_PH == 2) PH(2) phase_scan(p, lds);
    SYNC(2)
    PH(3) { attn_phase<0>(p, lds); attn_phase<1>(p, lds); }
    if (REP_PH == 3) PH(3) { attn_phase<0>(p, lds); attn_phase<1>(p, lds); }
    SYNC(3)
    PH(4) { EpiRes2 e{p.in[0], p.out, hb, sumsq + T_TOK, nullptr}; GEMM(EpiRes2, e, mixed, (const bf16_t*)(ws + WS_WT_OUT0), 1024, 1024) }
    SYNC(4)
    PH(5) { EpiUp2 e{sumsq + T_TOK, U}; GEMM(EpiUp2, e, hb, (const bf16_t*)(ws + WS_WT_UP0), 4096, 1024) }
    if (REP_PH == 5) PH(5) { EpiUp2 e{sumsq + T_TOK, U}; GEMM(EpiUp2, e, hb, (const bf16_t*)(ws + WS_WT_UP0), 4096, 1024) }
    SYNC(5)
    PH(6) { EpiRes2 e{p.out, p.out, hb, sumsq + 2 * T_TOK, sumsq + T_TOK}; GEMM(EpiRes2, e, U, (const bf16_t*)(ws + WS_WT_DN0), 1024, 4096) }
    SYNC(6)
    PH(7) { EpiProj1b e{sumsq + 2 * T_TOK, pbuf, vt, (float*)(ws + WS_BITMASK), (float*)(ws + WS_IW), rope}; GEMM(EpiProj1b, e, hb, (const bf16_t*)(ws + WS_WT_IN1), 3840, 1024) }
    if (REP_PH == 7) PH(7) { EpiProj1b e{sumsq + 2 * T_TOK, pbuf, vt, (float*)(ws + WS_BITMASK), (float*)(ws + WS_IW), rope}; GEMM(EpiProj1b, e, hb, (const bf16_t*)(ws + WS_WT_IN1), 3840, 1024) }
    SYNC(7)
    PH(8) phase_iknorm(p);
    if (REP_PH == 200) { for (int i_ = 0; i_ < 10; ++i_) grid.sync(); }
    SYNC(8)
    PH(9) phase_index(p, lds);
    if (REP_PH == 9) PH(9) phase_index(p, lds);
    SYNC(9)
    if (REP_PH == 110) PH(10) attn_phase<2, 1>(p, lds);
    PH(10) attn_phase<2>(p, lds);
    if (REP_PH == 10) PH(10) attn_phase<2>(p, lds);
    SYNC(10)
    PH(11) { EpiRes2 e{p.out, p.out, hb, sumsq + 3 * T_TOK, nullptr}; GEMM(EpiRes2, e, mixed, (const bf16_t*)(ws + WS_WT_OUT1), 1024, 1024) }
    SYNC(11)
    PH(12) { EpiUp2 e{sumsq + 3 * T_TOK, U}; GEMM(EpiUp2, e, hb, (const bf16_t*)(ws + WS_WT_UP1), 4096, 1024) }
    SYNC(12)
    PH(13) { EpiRes2 e{p.out, p.out, nullptr, sumsq + 4 * T_TOK, sumsq + 3 * T_TOK}; GEMM(EpiRes2, e, U, (const bf16_t*)(ws + WS_WT_DN1), 1024, 4096) }
    SYNC(13)
    PH(14) phase_final(p);
}

extern "C" void kernel_launch(void* const* d_in, const int* in_sizes, int n_in, void* d_out, int out_size, void* d_ws, size_t ws_size, hipStream_t stream) {
    static int grid_blocks = 0;
    if (grid_blocks == 0) {
        if (n_in != 18 || ws_size < WS_END) { fprintf(stderr, "kernel_launch: unexpected n_in %d / ws_size %zu (need %zu)\n", n_in, ws_size, (size_t)WS_END); grid_blocks = -1; return; }
        int dev = 0, cus = 0, per_cu = 0;
        hipGetDevice(&dev);
        hipDeviceGetAttribute(&cus, hipDeviceAttributeMultiprocessorCount, dev);
        hipFuncSetAttribute((const void*)fwd_megakernel, hipFuncAttributeMaxDynamicSharedMemorySize, LDS_BYTES);
        hipOccupancyMaxActiveBlocksPerMultiprocessor(&per_cu, (const void*)fwd_megakernel, NTHREADS, LDS_BYTES);
        if (per_cu < 1) { fprintf(stderr, "kernel_launch: occupancy query says %d blocks/CU\n", per_cu); per_cu = 1; }
        (void)hipGetLastError();
        grid_blocks = cus;
    }
    if (grid_blocks < 0) return;
    Params p{};
    for (int i = 0; i < 18; ++i) p.in[i] = (const float*)d_in[i];
    p.out = (float*)d_out; p.ws = (unsigned char*)d_ws;
    for (int i = 0; i < 8; ++i) p.inv_freq[i] = (float)pow(500000.0, -(2.0 * i) / 16.0);
    p.ph_lo = 0; p.ph_hi = 15;
    void* args[] = {&p};
    hipError_t e = hipLaunchCooperativeKernel((const void*)fwd_megakernel, dim3(grid_blocks), dim3(NTHREADS), args, LDS_BYTES, stream);
    if (e != hipSuccess) fprintf(stderr, "cooperative launch failed: %s (grid %d)\n", hipGetErrorString(e), grid_blocks);
}
```
